# Optimizing an MI355X kernel written in HIP

```python
import math
import jax, jax.numpy as jnp
from jax import lax
import numpy as np

D_MODEL = 1024
BATCH = 16
SEQ = 2048
DEPTH = 4

CHUNK = 64
MIX_WIDTH = D_MODEL
CONV_WIDTH = MIX_WIDTH // 2
SSM_WIDTH = MIX_WIDTH - CONV_WIDTH
CONV_HEADS = 8
CONV_KERNEL = 31
SSM_GROUP = 16
SSM_GROUPS = SSM_WIDTH // SSM_GROUP
SSM_STATE = 64
DT_MIN = 1e-3
DT_MAX = 1e-1
IN_WIDTH = 2 * CONV_WIDTH + SSM_WIDTH
MOE_GROUPS = 4
EXPERTS_PER_GROUP = 8
N_EXPERTS = MOE_GROUPS * EXPERTS_PER_GROUP
TOP_K = 2
D_EXPERT = D_MODEL // 2
MOE_BLOCK = 128
EPS = 1e-6

kernel_name = "hybrid_conv_s5_hmoe_encoder"


def rms_norm(x, g):
    xf = x.astype(jnp.float32)
    y = xf * lax.rsqrt(jnp.mean(xf * xf, axis=-1, keepdims=True) + EPS)
    return (y * g.astype(jnp.float32)).astype(x.dtype)


def layer_norm(x, g, b):
    xf = x.astype(jnp.float32)
    mu = jnp.mean(xf, axis=-1, keepdims=True)
    xc = xf - mu
    y = xc * lax.rsqrt(jnp.mean(xc * xc, axis=-1, keepdims=True) + EPS)
    return (y * g.astype(jnp.float32) + b.astype(jnp.float32)).astype(x.dtype)


def conformer_conv(v, gate, w, b, ln_g, ln_b):
    u = v * jax.nn.sigmoid(gate)
    up = jnp.pad(u, ((0, 0), (CONV_KERNEL - 1, 0), (0, 0)))
    y = lax.conv_general_dilated(up, w[:, None, :], window_strides=(1,), padding='VALID',
                                 dimension_numbers=('NWC', 'WIO', 'NWC'),
                                 feature_group_count=CONV_WIDTH) + b
    y = layer_norm(y, ln_g, ln_b)
    return jax.nn.silu(y)


def _complex_scan_combine(left, right):
    a1r, a1i, b1r, b1i = left
    a2r, a2i, b2r, b2i = right
    return (a2r * a1r - a2i * a1i,
            a2r * a1i + a2i * a1r,
            a2r * b1r - a2i * b1i + b2r,
            a2r * b1i + a2i * b1r + b2i)


def s5_ssm(u, lam_re, lam_im, log_dt, b_re, b_im, c_re, c_im, d, glu_w, glu_b):
    f32 = jnp.float32
    bsz, seq, _ = u.shape
    uf = u.astype(f32)
    ug = uf.reshape(bsz, seq, SSM_GROUPS, SSM_GROUP)
    dt = jnp.exp(log_dt.astype(f32))[:, None]
    lr = lam_re.astype(f32)
    li = lam_im.astype(f32)
    mag = jnp.exp(lr * dt)
    ab_re = mag * jnp.cos(li * dt)
    ab_im = mag * jnp.sin(li * dt)
    den = lr * lr + li * li
    nr = ab_re - 1.0
    q_re = (nr * lr + ab_im * li) / den
    q_im = (ab_im * lr - nr * li) / den
    br = b_re.astype(f32)
    bi = b_im.astype(f32)
    bb_re = q_re[..., None] * br - q_im[..., None] * bi
    bb_im = q_re[..., None] * bi + q_im[..., None] * br
    drv_re = jnp.einsum('bsgc,gnc->sbgn', ug, bb_re)
    drv_im = jnp.einsum('bsgc,gnc->sbgn', ug, bb_im)
    a_re = jnp.broadcast_to(ab_re[None, None], (seq, 1, SSM_GROUPS, SSM_STATE))
    a_im = jnp.broadcast_to(ab_im[None, None], (seq, 1, SSM_GROUPS, SSM_STATE))
    _, _, h_re, h_im = lax.associative_scan(_complex_scan_combine,
                                            (a_re, a_im, drv_re, drv_im), axis=0)
    y = (jnp.einsum('sbgn,gcn->bsgc', h_re, c_re.astype(f32))
         - jnp.einsum('sbgn,gcn->bsgc', h_im, c_im.astype(f32)))
    y = y.reshape(bsz, seq, SSM_WIDTH) + d.astype(f32) * uf
    y = jax.nn.gelu(y).astype(u.dtype)
    return y * jax.nn.sigmoid(y @ glu_w + glu_b)


def hierarchical_moe(x, w_rg, b_rg, w_re, b_re, w_gate, w_up, w_down):
    f32 = jnp.float32
    bsz, seq, dm = x.shape
    n_tok = bsz * seq
    xt = x.reshape(n_tok, dm)
    xf = xt.astype(f32)
    tok_idx = jnp.arange(n_tok)
    g_logits = xf @ w_rg.astype(f32) + b_rg.astype(f32)
    g_prob = jax.nn.softmax(g_logits, axis=-1)
    grp = jnp.argmax(g_logits, axis=-1)
    p_grp = g_prob[tok_idx, grp]
    e_logits = (xf @ w_re.astype(f32) + b_re.astype(f32)).reshape(n_tok, MOE_GROUPS, EXPERTS_PER_GROUP)
    e_in = e_logits[tok_idx, grp]
    top_v, top_i = lax.top_k(e_in, TOP_K)
    gates = jax.nn.softmax(top_v, axis=-1) * p_grp[:, None]
    expert = (grp[:, None] * EXPERTS_PER_GROUP + top_i).reshape(-1).astype(jnp.int32)
    gate = gates.reshape(-1)
    token = jnp.repeat(tok_idx, TOP_K).astype(jnp.int32)
    n_asg = n_tok * TOP_K
    n_blocks = -(-n_asg // MOE_BLOCK) + N_EXPERTS
    cap = n_blocks * MOE_BLOCK
    order = jnp.argsort(expert)
    e_sorted = expert[order]
    counts = jnp.bincount(expert, length=N_EXPERTS)
    starts = jnp.cumsum(counts) - counts
    padded = (counts + MOE_BLOCK - 1) // MOE_BLOCK * MOE_BLOCK
    pad_ends = jnp.cumsum(padded)
    pad_starts = pad_ends - padded
    slot = pad_starts[e_sorted] + jnp.arange(n_asg) - starts[e_sorted]
    slot_token = jnp.full((cap,), n_tok, jnp.int32).at[slot].set(token[order])
    slot_gate = jnp.zeros((cap,), f32).at[slot].set(gate[order])
    block_expert = jnp.minimum(
        jnp.searchsorted(pad_ends, jnp.arange(n_blocks) * MOE_BLOCK, side='right'), N_EXPERTS - 1)
    x_pad = jnp.concatenate([xt, jnp.zeros((1, dm), xt.dtype)], axis=0)
    xb = x_pad[slot_token].reshape(n_blocks, MOE_BLOCK, dm)

    def expert_block(args):
        xblk, e = args
        hid = jax.nn.silu(xblk @ w_gate[e]) * (xblk @ w_up[e])
        return hid @ w_down[e]

    yb = lax.map(expert_block, (xb, block_expert)).reshape(cap, dm)
    y = jax.ops.segment_sum(yb.astype(f32) * slot_gate[:, None], slot_token, num_segments=n_tok + 1)[:n_tok]
    return y.astype(x.dtype).reshape(bsz, seq, dm)


def setup_inputs(seed: int = 0) -> dict:
    key = jax.random.key(seed)
    ks = jax.random.split(key, 32)
    f32 = jnp.float32
    L = DEPTH

    def nrm(k, shape, scale):
        return jax.random.normal(k, shape, f32) * scale

    x = jax.random.normal(ks[0], (BATCH, SEQ, D_MODEL), f32)
    g_mix = 1.0 + nrm(ks[1], (L, D_MODEL), 0.02)
    w_in = nrm(ks[2], (L, D_MODEL, IN_WIDTH), D_MODEL ** -0.5)
    conv_w = nrm(ks[3], (L, CONV_KERNEL, CONV_WIDTH), CONV_KERNEL ** -0.5)
    conv_b = nrm(ks[4], (L, CONV_WIDTH), 0.02)
    conv_ln_g = 1.0 + nrm(ks[5], (L, CONV_WIDTH), 0.02)
    conv_ln_b = nrm(ks[6], (L, CONV_WIDTH), 0.02)
    ssm_lam_re = -0.5 * jnp.exp(nrm(ks[7], (L, SSM_GROUPS, SSM_STATE), 0.05))
    ssm_lam_im = (jnp.pi * jnp.arange(SSM_STATE, dtype=f32))[None, None, :] + nrm(ks[8], (L, SSM_GROUPS, SSM_STATE), 0.01)
    ssm_log_dt = jax.random.uniform(ks[9], (L, SSM_GROUPS), f32, math.log(DT_MIN), math.log(DT_MAX))
    ssm_b_re = nrm(ks[10], (L, SSM_GROUPS, SSM_STATE, SSM_GROUP), (2 * SSM_GROUP) ** -0.5)
    ssm_b_im = nrm(ks[11], (L, SSM_GROUPS, SSM_STATE, SSM_GROUP), (2 * SSM_GROUP) ** -0.5)
    ssm_c_re = nrm(ks[12], (L, SSM_GROUPS, SSM_GROUP, SSM_STATE), (2 * SSM_STATE) ** -0.5)
    ssm_c_im = nrm(ks[13], (L, SSM_GROUPS, SSM_GROUP, SSM_STATE), (2 * SSM_STATE) ** -0.5)
    ssm_d = nrm(ks[14], (L, SSM_WIDTH), 1.0)
    ssm_glu_w = nrm(ks[15], (L, SSM_WIDTH, SSM_WIDTH), SSM_WIDTH ** -0.5)
    ssm_glu_b = nrm(ks[16], (L, SSM_WIDTH), 0.02)
    g_branch = 1.0 + nrm(ks[17], (L, MIX_WIDTH), 0.02)
    w_out = nrm(ks[18], (L, MIX_WIDTH, D_MODEL), MIX_WIDTH ** -0.5)
    g_ffn = 1.0 + nrm(ks[19], (L, D_MODEL), 0.02)
    w_router_group = nrm(ks[20], (L, D_MODEL, MOE_GROUPS), D_MODEL ** -0.5)
    b_router_group = nrm(ks[21], (L, MOE_GROUPS), 0.01)
    w_router_expert = nrm(ks[22], (L, D_MODEL, N_EXPERTS), D_MODEL ** -0.5)
    b_router_expert = nrm(ks[23], (L, N_EXPERTS), 0.01)
    w_gate = nrm(ks[24], (L, N_EXPERTS, D_MODEL, D_EXPERT), D_MODEL ** -0.5)
    w_up = nrm(ks[25], (L, N_EXPERTS, D_MODEL, D_EXPERT), D_MODEL ** -0.5)
    w_down = nrm(ks[26], (L, N_EXPERTS, D_EXPERT, D_MODEL), D_EXPERT ** -0.5)
    g_final = 1.0 + nrm(ks[27], (D_MODEL,), 0.02)
    return {"x": x, "g_mix": g_mix, "w_in": w_in, "conv_w": conv_w, "conv_b": conv_b,
            "conv_ln_g": conv_ln_g, "conv_ln_b": conv_ln_b,
            "ssm_lam_re": ssm_lam_re, "ssm_lam_im": ssm_lam_im, "ssm_log_dt": ssm_log_dt,
            "ssm_b_re": ssm_b_re, "ssm_b_im": ssm_b_im, "ssm_c_re": ssm_c_re, "ssm_c_im": ssm_c_im,
            "ssm_d": ssm_d, "ssm_glu_w": ssm_glu_w, "ssm_glu_b": ssm_glu_b,
            "g_branch": g_branch, "w_out": w_out, "g_ffn": g_ffn,
            "w_router_group": w_router_group, "b_router_group": b_router_group,
            "w_router_expert": w_router_expert, "b_router_expert": b_router_expert,
            "w_gate": w_gate, "w_up": w_up, "w_down": w_down, "g_final": g_final}


def reference(x, g_mix, w_in, conv_w, conv_b, conv_ln_g, conv_ln_b,
              ssm_lam_re, ssm_lam_im, ssm_log_dt, ssm_b_re, ssm_b_im, ssm_c_re, ssm_c_im,
              ssm_d, ssm_glu_w, ssm_glu_b, g_branch, w_out, g_ffn,
              w_router_group, b_router_group, w_router_expert, b_router_expert,
              w_gate, w_up, w_down, g_final):
    for l in range(DEPTH):
        h = rms_norm(x, g_mix[l])
        z = h @ w_in[l]
        c_val = z[..., :CONV_WIDTH]
        c_gate = z[..., CONV_WIDTH:2 * CONV_WIDTH]
        s_in = z[..., 2 * CONV_WIDTH:]
        y_conv = conformer_conv(c_val, c_gate, conv_w[l], conv_b[l], conv_ln_g[l], conv_ln_b[l])
        y_ssm = s5_ssm(s_in, ssm_lam_re[l], ssm_lam_im[l], ssm_log_dt[l], ssm_b_re[l], ssm_b_im[l],
                       ssm_c_re[l], ssm_c_im[l], ssm_d[l], ssm_glu_w[l], ssm_glu_b[l])
        gb = g_branch[l]
        y_cat = jnp.concatenate([rms_norm(y_conv, gb[:CONV_WIDTH]),
                                 rms_norm(y_ssm, gb[CONV_WIDTH:])], axis=-1)
        x = x + y_cat @ w_out[l]
        h = rms_norm(x, g_ffn[l])
        x = x + hierarchical_moe(h, w_router_group[l], b_router_group[l],
                                 w_router_expert[l], b_router_expert[l],
                                 w_gate[l], w_up[l], w_down[l])
    return rms_norm(x, g_final)
```

```cpp
#include <hip/hip_runtime.h>
#include <cstdio>
#include <cstdint>

#ifndef DUP_MASK
#define DUP_MASK 0
#endif
#ifndef MK_ONE_LAUNCH
#define MK_ONE_LAUNCH 1
#endif

namespace {
#define LAS __attribute__((address_space(3)))
#define GAS __attribute__((address_space(1)))
typedef float f32x4 __attribute__((ext_vector_type(4)));
typedef int i32x4 __attribute__((ext_vector_type(4)));

constexpr int DM = 1024, BATCH = 16, SEQ = 2048, DEPTH = 4, NTOK = BATCH * SEQ;
constexpr int CW = 512, SW = 512, CKW = 31, SGC = 16, NG = 32, NS = 64, INW = 1536;
constexpr int MG = 4, EPG = 8, NE = 32, DE = 512;
constexpr float EPS = 1e-6f;
__device__ __forceinline__ float eps_() { float e = EPS; asm volatile("" : "+v"(e)); return e; }
constexpr int NTHREADS = 512, NWAVES = 8;
constexpr int LDS_BYTES = 147456;

constexpr size_t MiB = 1u << 20;
constexpr size_t WS_CTL = 0;
constexpr size_t CTL_BYTES = 64 * 1024;
constexpr size_t WS_CNT = CTL_BYTES;
constexpr size_t WS_CQ = CTL_BYTES + 32768;
constexpr size_t WS_TC = 128 * 1024;
constexpr size_t WS_WMAX = WS_TC + DEPTH * 288 * 256;
constexpr size_t WS_WME = WS_WMAX + DEPTH * 1536 * 4;
constexpr size_t WS_WMAXO = WS_WME + (size_t)DEPTH * 32 * 1024 * 4;
constexpr size_t ZERO_BYTES = WS_WMAXO + DEPTH * 1024 * 4;
constexpr size_t WS_R1 = 8 * MiB;
constexpr size_t WS_X8 = WS_R1 + 96 * MiB;
constexpr size_t WS_X8B = WS_R1 + 128 * MiB;
constexpr size_t WS_WGU8 = WS_R1 + 160 * MiB;
constexpr size_t WS_R3 = WS_R1 + 192 * MiB;
constexpr size_t WS_SQA = WS_R3 + 72 * MiB;
constexpr size_t WS_HH = WS_R3 + 128 * MiB;
constexpr size_t WS_YH = WS_HH + 64 * MiB;
constexpr size_t WS_SIGS = WS_YH + 32 * MiB;
constexpr size_t WS_SIGC = WS_YH + 33 * MiB;
constexpr size_t WS_VH = WS_YH + 64 * MiB;
constexpr size_t WS_WIN = WS_VH + 32 * MiB;
constexpr size_t WS_GLU = WS_WIN + 3 * MiB;
constexpr size_t WS_WOUT = WS_GLU + 1 * MiB;
constexpr size_t WS_WGU = WS_WOUT + 2 * MiB;
constexpr size_t WS_WD = WS_WGU + 64 * MiB;
constexpr size_t WS_U = WS_WD + 32 * MiB;
constexpr size_t WS_SG = WS_U + 32 * MiB;
constexpr size_t WS_BS = WS_SG + 40 * MiB;
constexpr size_t WS_MY = WS_BS + 8 * MiB;
constexpr size_t WS_AT = WS_MY + 20 * MiB;
constexpr size_t WS_SSQ2 = WS_AT + 1 * MiB;
constexpr size_t WS_SSQ1 = WS_SSQ2 + 1 * MiB;
constexpr size_t WS_WR = WS_SSQ1 + 2 * MiB;
constexpr size_t WS_RR0 = WS_WR + 1 * MiB;
constexpr size_t WS_RR1 = WS_RR0 + 1 * MiB;
constexpr size_t WS_LIST = WS_RR1 + 1 * MiB;
constexpr size_t WS_W2 = WS_LIST + 16 * MiB;
constexpr size_t WS_END = WS_W2 + 96 * MiB;

#define XB_TMO      128
#define XB_XCNT(j)  (256  + 64 * (j))
#define XB_XSUB(j)  (1280 + 64 * (j))
#define XB_XGEN(j)  (2304 + 64 * (j))
#define XB_TOP      3328
#define XB_TOPGEN   3392
#define XCD_BAR_WORDS 3456
#define XB_SPIN_CAP (1u << 22)

__device__ __forceinline__ unsigned xb_ld(unsigned* p)              { return __hip_atomic_load(p, __ATOMIC_RELAXED, __HIP_MEMORY_SCOPE_AGENT); }
__device__ __forceinline__ unsigned xb_add(unsigned* p, unsigned v) { return __hip_atomic_fetch_add(p, v, __ATOMIC_RELAXED, __HIP_MEMORY_SCOPE_AGENT); }
__device__ __forceinline__ unsigned xb_xcc_id() { return (unsigned)__builtin_amdgcn_s_getreg((3 << 11) | 20) & 0xFu; }
#define XB_SPIN(cond, bar) do { unsigned _sp = 0; while (cond) { __builtin_amdgcn_s_sleep(1); \
    if ((++_sp & 255u) == 0u) { if (xb_ld(&(bar)[XB_TMO])) break; if (_sp > XB_SPIN_CAP) { atomicAdd(&(bar)[XB_TMO], 1u); break; } } } } while (0)

struct XcdBarrier { unsigned* bar; unsigned x; volatile LAS unsigned* st; };

__device__ __forceinline__ XcdBarrier xcd_barrier_post(unsigned* bar, volatile LAS unsigned* st) {
    XcdBarrier b; b.bar = bar; b.x = xb_xcc_id(); b.st = st;
    if (threadIdx.x == 0) (void)xb_add(&bar[XB_XCNT(b.x)], 1u);
    return b;
}
__device__ __forceinline__ void xcd_barrier_complete(unsigned* bar, unsigned x, unsigned& nloc, unsigned& nx) {
    const unsigned G = gridDim.x * gridDim.y * gridDim.z;
    unsigned sum, cnt, mine, sp = 0u;
    for (;;) {
        sum = 0u; cnt = 0u; mine = 0u;
#pragma unroll
        for (unsigned j = 0; j < 16; ++j) { const unsigned c = xb_ld(&bar[XB_XCNT(j)]); sum += c; cnt += (c > 0u) ? 1u : 0u; mine = (j == x) ? c : mine; }
        if (sum == G) break;
        __builtin_amdgcn_s_sleep(1);
        if ((++sp & 255u) == 0u) { if (xb_ld(&bar[XB_TMO])) break; if (sp > XB_SPIN_CAP) { atomicAdd(&bar[XB_TMO], 1u); break; } }
    }
    nloc = mine > 0u ? mine : 1u; nx = cnt > 0u ? cnt : 1u;
}
__device__ __forceinline__ void xcd_barrier(const XcdBarrier& b) {
    asm volatile("s_waitcnt vmcnt(0)" ::: "memory");
    __syncthreads();
    if (threadIdx.x == 0) {
        unsigned* bar = b.bar;
        __builtin_amdgcn_s_waitcnt(0);
        unsigned nloc = b.st[0], nx = b.st[1];
        if (nloc == 0u) { xcd_barrier_complete(bar, b.x, nloc, nx); b.st[0] = nloc; b.st[1] = nx; }
        const unsigned old = xb_add(&bar[XB_XSUB(b.x)], 1u);
        const unsigned gen = old / nloc;
        if (old + 1u == (gen + 1u) * nloc) {
            __builtin_amdgcn_fence(__ATOMIC_RELEASE, "agent");
            asm volatile("s_waitcnt vmcnt(0)" ::: "memory");
            const unsigned og = xb_add(&bar[XB_TOP], 1u);
            const unsigned tg = og / nx;
            if (og + 1u == (tg + 1u) * nx) xb_add(&bar[XB_TOPGEN], 1u);
            else XB_SPIN(xb_ld(&bar[XB_TOPGEN]) == tg, bar);
            __builtin_amdgcn_fence(__ATOMIC_ACQUIRE, "agent");
            xb_add(&bar[XB_XGEN(b.x)], 1u);
            asm volatile("s_waitcnt vmcnt(0)" ::: "memory");
        } else {
            XB_SPIN(xb_ld(&bar[XB_XGEN(b.x)]) == gen, bar);
            __builtin_amdgcn_fence(__ATOMIC_ACQUIRE, "agent");
            asm volatile("s_waitcnt vmcnt(0)" ::: "memory");
        }
    }
    __syncthreads();
}

__device__ __forceinline__ int lane_id_() { int ln; asm volatile("v_mbcnt_lo_u32_b32 %0, -1, 0\n\tv_mbcnt_hi_u32_b32 %0, -1, %0" : "=v"(ln)); return ln; }
__device__ __forceinline__ float wave_sum(float v, int lane) {
#pragma unroll
    for (int o = 1; o < 64; o <<= 1) v += __builtin_bit_cast(float, __builtin_amdgcn_ds_bpermute((lane ^ o) << 2, __builtin_bit_cast(int, v)));
    return v;
}

__device__ __forceinline__ float wave_max(float v, int lane) {
#pragma unroll
    for (int o = 1; o < 64; o <<= 1) v = fmaxf(v, __builtin_bit_cast(float, __builtin_amdgcn_ds_bpermute((lane ^ o) << 2, __builtin_bit_cast(int, v))));
    return v;
}
__device__ __forceinline__ unsigned pk_i8(float a, float b, float c, float d, float inv) {
    unsigned w = __builtin_amdgcn_cvt_pk_u8_f32(__builtin_rintf(__builtin_fmaf(a, inv, 128.0f)), 0u, 0u);
    w = __builtin_amdgcn_cvt_pk_u8_f32(__builtin_rintf(__builtin_fmaf(b, inv, 128.0f)), 1u, w); w = __builtin_amdgcn_cvt_pk_u8_f32(__builtin_rintf(__builtin_fmaf(c, inv, 128.0f)), 2u, w);
    w = __builtin_amdgcn_cvt_pk_u8_f32(__builtin_rintf(__builtin_fmaf(d, inv, 128.0f)), 3u, w);
    return w ^ 0x80808080u;
}
__device__ __forceinline__ unsigned pk_u8o(float a, float b, float c, float d, float inv) {
    unsigned w = __builtin_amdgcn_cvt_pk_u8_f32(__builtin_rintf(__builtin_fmaf(a, inv, 128.0f)), 0u, 0u);
    w = __builtin_amdgcn_cvt_pk_u8_f32(__builtin_rintf(__builtin_fmaf(b, inv, 128.0f)), 1u, w); w = __builtin_amdgcn_cvt_pk_u8_f32(__builtin_rintf(__builtin_fmaf(c, inv, 128.0f)), 2u, w);
    return __builtin_amdgcn_cvt_pk_u8_f32(__builtin_rintf(__builtin_fmaf(d, inv, 128.0f)), 3u, w);
}
typedef _Float16 h16;
typedef _Float16 h16x8 __attribute__((ext_vector_type(8)));
typedef _Float16 h16x2 __attribute__((ext_vector_type(2)));
typedef _Float16 h16x4 __attribute__((ext_vector_type(4)));
typedef unsigned u32x4 __attribute__((ext_vector_type(4)));
typedef unsigned u32x2 __attribute__((ext_vector_type(2)));
__device__ __forceinline__ unsigned pk_h16(float a, float b) { h16x2 v = {(h16)a, (h16)b}; return __builtin_bit_cast(unsigned, v); }
namespace eng {
constexpr int BM = 256, BK = 64, HALF = 128, HTB = HALF * BK * 2, STAGE_BYTES = 8 * HTB, NXCD = 8, WGM = 8;
__host__ __device__ __forceinline__ int lds_byte(int r, int c) { const int st = (r >> 4) * 2 + (c >> 5), rr = r & 15, cc = c & 31, ob = rr * 64 + cc * 2; return st * 1024 + (ob ^ (((ob >> 9) & 1) << 5)); }
__host__ __device__ __forceinline__ void stage_rc(int b, int& R, int& C) { const int st = b / 1024, sb = b % 1024, swz = sb ^ (((sb >> 9) & 1) << 5); R = (st >> 1) * 16 + swz / 64; C = (st & 1) * 32 + (swz % 64) / 2; }
__host__ __device__ __forceinline__ int perm32(int rho) { const int n = rho >> 4, i = rho & 15; return 8 * (i >> 2) + 4 * n + (i & 3); }
struct Unit { unsigned ao, bo; int pm, pn, e, aux; int nt = 0, kcut = 1 << 20, kskip = 0; };
struct Geo { unsigned ldb, kstepA, kstepB; int nt; int krot = 0, mid = -1, mid2 = -1; };
template <class Epi, class Sched>
__device__ __forceinline__ void gemm_phase(LAS unsigned char* lds, const Geo g, const void* Abase, const void* Bbase, const Sched& S, const Epi& E, int wv) {
    const __amdgpu_buffer_rsrc_t rA = __builtin_amdgcn_make_buffer_rsrc((void*)Abase, 0, 0xFFFFFFF0u, 0x00020000), rB = __builtin_amdgcn_make_buffer_rsrc((void*)Bbase, 0, 0xFFFFFFF0u, 0x00020000);
    int tid = wv * 64 + lane_id_(); asm volatile("" : "+v"(tid));
    const int wid = __builtin_amdgcn_readfirstlane(tid >> 6), lane = tid & 63, wr = wid >> 2, wc = wid & 3, fr = lane & 15, fq = lane >> 4;
    const int nt = g.nt;
    unsigned voffB[2];
#pragma unroll
    for (int i = 0; i < 2; ++i) { int R, C; stage_rc(tid * 16 + i * 8192, R, C); const int Rb = Epi::PERM ? ((R & ~31) + perm32(R & 31)) : R; voffB[i] = (unsigned)Rb * g.ldb + (unsigned)C * 2u; }
    const unsigned hstepB = (unsigned)HALF * g.ldb;
    const unsigned kA = g.kstepA, kB = g.kstepB;
    const unsigned ldsw = (unsigned)wid * 1024u;
    const int aoff = lds_byte(wr * 64 + fr, fq * 8), boff = lds_byte(wc * 32 + fr, fq * 8);
#define EG_SA(b, h) (((b) * 2 + (h)) * HTB)
#define EG_SB(b, h) ((4 + (b) * 2 + (h)) * HTB)
#define EG_STAGE(bufoff, so, v0, v1) do { \
        __builtin_amdgcn_raw_ptr_buffer_load_lds(rA, (LAS void*)(lds + (bufoff) + ldsw), 16, (v0), (so), 0, 0); \
        __builtin_amdgcn_raw_ptr_buffer_load_lds(rA, (LAS void*)(lds + (bufoff) + ldsw + 8192), 16, (v1), (so), 0, 0); } while (0)
#define EG_STB(bufoff, so) do { \
        __builtin_amdgcn_raw_ptr_buffer_load_lds(rB, (LAS void*)(lds + (bufoff) + ldsw), 16, voffB[0], (so), 0, 0); \
        __builtin_amdgcn_raw_ptr_buffer_load_lds(rB, (LAS void*)(lds + (bufoff) + ldsw + 8192), 16, voffB[1], (so), 0, 0); } while (0)
#define EG_LDA(dst, b, h) do { _Pragma("unroll") for (int m = 0; m < 4; ++m) _Pragma("unroll") for (int k = 0; k < 2; ++k) dst[m][k] = *(const LAS h16x8*)(lds + EG_SA(b, h) + aoff + m * 2048 + k * 1024); } while (0)
#define EG_LDB(dst, b, h) do { _Pragma("unroll") for (int n = 0; n < 2; ++n) _Pragma("unroll") for (int k = 0; k < 2; ++k) dst[n][k] = *(const LAS h16x8*)(lds + EG_SB(b, h) + boff + n * 2048 + k * 1024); } while (0)
#define EG_MMA(ai, bj, At, Bt) do { __builtin_amdgcn_s_setprio(1); _Pragma("unroll") for (int m = 0; m < 4; ++m) _Pragma("unroll") for (int n = 0; n < 2; ++n) _Pragma("unroll") for (int k = 0; k < 2; ++k) { \
        if constexpr (Epi::I8) acc[ai][bj][m][n] = __builtin_bit_cast(f32x4, __builtin_amdgcn_mfma_i32_16x16x64_i8(__builtin_bit_cast(i32x4, Bt[n][k]), __builtin_bit_cast(i32x4, At[m][k]), __builtin_bit_cast(i32x4, acc[ai][bj][m][n]), 0, 0, 0)); \
        else acc[ai][bj][m][n] = __builtin_amdgcn_mfma_f32_16x16x32_f16(Bt[n][k], At[m][k], acc[ai][bj][m][n], 0, 0, 0); } __builtin_amdgcn_s_setprio(0); } while (0)
#define EG_WAIT_V(n) asm volatile("s_waitcnt vmcnt(" #n ")" ::: "memory")
#define EG_WAIT_L(n) asm volatile("s_waitcnt lgkmcnt(" #n ")" ::: "memory")
#define EG_BAR __builtin_amdgcn_s_barrier()
#define EG_SCHED __builtin_amdgcn_sched_barrier(0)
    Unit cur, nxt; int ui = 0, pub = -1;
    if (!S.next(0, cur)) return;
    f32x4 acc[2][2][4][2];
#pragma unroll
    for (int a = 0; a < 2; ++a)
#pragma unroll
        for (int b = 0; b < 2; ++b)
#pragma unroll
            for (int m = 0; m < 4; ++m)
#pragma unroll
                for (int n = 0; n < 2; ++n) acc[a][b][m][n] = (f32x4){0.f, 0.f, 0.f, 0.f};
    h16x8 At[4][2], B0[2][2], B1[2][2];
    unsigned cA = cur.ao, cB = cur.bo;
    unsigned cv[2][2], nv[2][2];
    S.a_ready(cur, tid);
    S.a_off(cur, tid, cv);
    if constexpr (Sched::GATHER) {
#pragma unroll
        for (int h = 0; h < 2; ++h)
#pragma unroll
            for (int i = 0; i < 2; ++i) nv[h][i] = cv[h][i];
    }
#define EG_SV(h, i) (Sched::GATHER ? (last ? nv[h][i] : cv[h][i]) : cv[h][i])
    const int krot = g.krot;
#define EG_KT(k) (Sched::KSKIP ? (unsigned)((k) + ((k) >= cur.kcut ? cur.kskip : 0)) : (unsigned)(((k) + krot) >= nt ? (k) + krot - nt : (k) + krot))
    EG_STB(EG_SB(0, 0), cB + EG_KT(0) * kB); EG_STB(EG_SB(0, 1), cB + hstepB + EG_KT(0) * kB); EG_STAGE(EG_SA(0, 0), cA + EG_KT(0) * kA, cv[0][0], cv[0][1]); EG_STAGE(EG_SA(0, 1), cA + EG_KT(0) * kA, cv[1][0], cv[1][1]);
    EG_STB(EG_SB(1, 0), cB + EG_KT(1) * kB); EG_STAGE(EG_SA(1, 0), cA + EG_KT(1) * kA, cv[0][0], cv[0][1]); EG_STB(EG_SB(1, 1), cB + hstepB + EG_KT(1) * kB);
    if (wr == 1) EG_BAR;
    EG_WAIT_V(8); EG_BAR;
    EG_WAIT_V(6); EG_BAR;
    for (;;) {
        const bool has_next = S.next(ui + 1, nxt);
        const unsigned nA = has_next ? nxt.ao : cA, nB = has_next ? nxt.bo : cB;
        if constexpr (Sched::GATHER) { if (has_next) S.a_off(nxt, tid, nv); }
        const int cnt = Sched::KSKIP ? cur.nt : nt;
        for (int t = 0; t < cnt; t += 2) {
            const bool last = (t == cnt - 2);
            const unsigned a1 = cA + EG_KT(t + 1) * kA;
            const unsigned a2 = last ? nA + EG_KT(0) * kA : cA + EG_KT(t + 2) * kA, b2 = last ? nB + EG_KT(0) * kB : cB + EG_KT(t + 2) * kB;
            const unsigned a3 = last ? nA + EG_KT(1) * kA : cA + EG_KT(t + 3) * kA, b3 = last ? nB + EG_KT(1) * kB : cB + EG_KT(t + 3) * kB;
            if constexpr (Epi::HAS_MID) { if (t == g.mid) E.mid(acc, cur, wr, wc, fr, fq, ui, 0); else if (t == g.mid2) E.mid(acc, cur, wr, wc, fr, fq, ui, 1); }
            if constexpr (Sched::WAITS) { if (last && has_next) S.a_ready(nxt, tid); }
            EG_LDB(B0, 0, 0); if constexpr (!Epi::ONLY_B0) EG_LDB(B1, 0, 1); EG_SCHED; EG_LDA(At, 0, 0); EG_STAGE(EG_SA(1, 1), a1, cv[1][0], cv[1][1]);
            EG_WAIT_V(8); EG_WAIT_L(0); EG_BAR; EG_MMA(0, 0, At, B0); if constexpr (!Epi::ONLY_B0) EG_MMA(0, 1, At, B1); EG_BAR; EG_SCHED;
            EG_LDA(At, 0, 1); EG_STB(EG_SB(0, 0), b2); EG_STB(EG_SB(0, 1), b2 + hstepB); EG_STAGE(EG_SA(0, 0), a2, EG_SV(0, 0), EG_SV(0, 1));
            EG_WAIT_V(8);
            if constexpr (Epi::PUBLISH) { if (pub >= 0) { E.publish(pub, lane); pub = -1; } }
            EG_WAIT_L(0); EG_BAR; EG_MMA(1, 0, At, B0); if constexpr (!Epi::ONLY_B0) EG_MMA(1, 1, At, B1); EG_BAR; EG_SCHED;
            EG_LDB(B0, 1, 0); if constexpr (!Epi::ONLY_B0) EG_LDB(B1, 1, 1); EG_SCHED; EG_LDA(At, 1, 0); EG_STAGE(EG_SA(0, 1), a2, EG_SV(1, 0), EG_SV(1, 1));
            EG_WAIT_V(8); EG_WAIT_L(0); EG_BAR; EG_MMA(0, 0, At, B0); if constexpr (!Epi::ONLY_B0) EG_MMA(0, 1, At, B1); EG_BAR; EG_SCHED;
            EG_LDA(At, 1, 1); EG_STB(EG_SB(1, 0), b3); EG_STB(EG_SB(1, 1), b3 + hstepB); EG_STAGE(EG_SA(1, 0), a3, EG_SV(0, 0), EG_SV(0, 1));
            EG_WAIT_V(8); EG_WAIT_L(0); EG_BAR; EG_MMA(1, 0, At, B0); if constexpr (!Epi::ONLY_B0) EG_MMA(1, 1, At, B1); EG_BAR; EG_SCHED;
        }
        if (wr == 0) EG_BAR;
        { int fr2 = fr, fq2 = fq; Unit ue = cur; asm volatile("" : "+v"(fr2), "+v"(fq2), "+s"(ue.pm), "+s"(ue.pn), "+s"(ue.e), "+s"(ue.aux)); if constexpr (Epi::HAS_MID) E(acc, ue, wr, wc, fr2, fq2, ui); else E(acc, ue, wr, wc, fr2, fq2); }
        if constexpr (Epi::PUBLISH) pub = cur.aux;
        if (!has_next) break;
#pragma unroll
        for (int a = 0; a < 2; ++a)
#pragma unroll
            for (int b = 0; b < 2; ++b)
#pragma unroll
                for (int m = 0; m < 4; ++m)
#pragma unroll
                    for (int n = 0; n < 2; ++n) acc[a][b][m][n] = (f32x4){0.f, 0.f, 0.f, 0.f};
        cur = nxt; cA = nA; cB = nB; ++ui;
        if constexpr (Sched::GATHER) {
#pragma unroll
            for (int h = 0; h < 2; ++h)
#pragma unroll
                for (int i = 0; i < 2; ++i) cv[h][i] = nv[h][i];
        }
        if (wr == 1) EG_BAR;
    }
    EG_WAIT_V(0);
    if constexpr (Epi::PUBLISH) { if (pub >= 0) E.publish(pub, lane); }
    EG_BAR;
    if constexpr (Epi::AFTER_DRAIN) E.fused(acc, cur, lds, tid, wr, wc, fr, fq);
#undef EG_SA
#undef EG_SV
#undef EG_KT
#undef EG_SB
#undef EG_STAGE
#undef EG_STB
#undef EG_LDA
#undef EG_LDB
#undef EG_MMA
#undef EG_WAIT_V
#undef EG_WAIT_L
#undef EG_BAR
#undef EG_SCHED
}
struct DenseOrder {
    int nM, nN, nwg, G, c; unsigned lda, ldb;
    __device__ __forceinline__ void init(int M, int N, int G_, int c_, unsigned lda_, unsigned ldb_) { nM = M / BM; nN = N / BM; nwg = nM * nN; G = G_; c = c_; lda = lda_; ldb = ldb_; }
    __device__ __forceinline__ bool next(int i, Unit& u) const {
        const long L = (long)i * G + c; if (L >= nwg) return false;
        int wgid = (int)L; { const int q = nwg / NXCD, r = nwg % NXCD, xcd = wgid % NXCD, off = wgid / NXCD; wgid = (xcd < r ? xcd * (q + 1) : r * (q + 1) + (xcd - r) * q) + off; }
        const int nig = WGM * nN, gid = wgid / nig, fm = gid * WGM, gsz = (nM - fm) < WGM ? (nM - fm) : WGM;
        u.pm = fm + ((wgid % nig) % gsz); u.pn = (wgid % nig) / gsz; u.e = 0; u.aux = 0;
        u.ao = (unsigned)u.pm * BM * lda; u.bo = (unsigned)u.pn * BM * ldb; return true;
    }
    __device__ __forceinline__ void a_off(const Unit&, int tid, unsigned (&v)[2][2]) const {
#pragma unroll
        for (int i = 0; i < 2; ++i) { int R, C; stage_rc(tid * 16 + i * 8192, R, C);
#pragma unroll
            for (int h = 0; h < 2; ++h) v[h][i] = (unsigned)(h * 128 + R) * lda + (unsigned)C * 2u; } }
    static constexpr bool GATHER = false, WAITS = false, KSKIP = false;
    __device__ __forceinline__ void a_ready(const eng::Unit&, int) const {}
};
}

__device__ __forceinline__ void transpose_item(const float* W, int ldw, h16* WT, int ldt, const float* ks, LAS float* scr, int k0, int n0, int drow0, int lane, float* wmax = nullptr) {
    const int nq = lane & 15, kr = lane >> 4;
    f32x4 v[16];
#pragma unroll
    for (int i = 0; i < 16; ++i) v[i] = __builtin_nontemporal_load((const f32x4*)(W + (size_t)(k0 + 4 * i + kr) * ldw + n0 + 4 * nq));
    if (ks) {
#pragma unroll
        for (int i = 0; i < 16; ++i) v[i] = v[i] * ks[k0 + 4 * i + kr]; }
    if (wmax) {
        f32x4 m = {0.f, 0.f, 0.f, 0.f};
#pragma unroll
        for (int i = 0; i < 16; ++i)
#pragma unroll
            for (int e = 0; e < 4; ++e) m[e] = fmaxf(m[e], fabsf(v[i][e]));
#pragma unroll
        for (int e = 0; e < 4; ++e) { float x = m[e];
            x = fmaxf(x, __builtin_bit_cast(float, __builtin_amdgcn_ds_bpermute((lane ^ 16) << 2, __builtin_bit_cast(int, x))));
            x = fmaxf(x, __builtin_bit_cast(float, __builtin_amdgcn_ds_bpermute((lane ^ 32) << 2, __builtin_bit_cast(int, x))));
            if (kr == 0) atomicMax((unsigned*)(wmax + drow0 + 4 * nq + e), __float_as_uint(x)); } }
#pragma unroll
    for (int i = 0; i < 16; ++i) { LAS float* d = scr + (4 * i + kr) * 65 + 4 * nq; d[0] = v[i][0]; d[1] = v[i][1]; d[2] = v[i][2]; d[3] = v[i][3]; }
    asm volatile("s_waitcnt lgkmcnt(0)" ::: "memory");
#pragma unroll
    for (int j = 0; j < 8; ++j) { const int id = lane + 64 * j, cc = id & 7, n = id >> 3; const LAS float* s = scr + (8 * cc) * 65 + n;
        u32x4 o; o.x = pk_h16(s[0 * 65], s[1 * 65]); o.y = pk_h16(s[2 * 65], s[3 * 65]); o.z = pk_h16(s[4 * 65], s[5 * 65]); o.w = pk_h16(s[6 * 65], s[7 * 65]);
        __builtin_nontemporal_store(o, (u32x4*)(WT + (size_t)(drow0 + n) * ldt + k0 + 8 * cc)); }
    asm volatile("s_waitcnt lgkmcnt(0)" ::: "memory");
}

__device__ __forceinline__ void absmax_item(const float* W, int ldw, const float* ks, float* wmax, int k0, int n0, int drow0, int lane) {
    const int nq = lane & 15, kr = lane >> 4;
    f32x4 v[16];
#pragma unroll
    for (int i = 0; i < 16; ++i) v[i] = *(const f32x4*)(W + (size_t)(k0 + 4 * i + kr) * ldw + n0 + 4 * nq);
    f32x4 m = {0.f, 0.f, 0.f, 0.f};
#pragma unroll
    for (int i = 0; i < 16; ++i) { const float g = ks[k0 + 4 * i + kr];
#pragma unroll
        for (int e = 0; e < 4; ++e) m[e] = fmaxf(m[e], fabsf(v[i][e] * g)); }
#pragma unroll
    for (int e = 0; e < 4; ++e) { float x = m[e];
        x = fmaxf(x, __builtin_bit_cast(float, __builtin_amdgcn_ds_bpermute((lane ^ 16) << 2, __builtin_bit_cast(int, x))));
        x = fmaxf(x, __builtin_bit_cast(float, __builtin_amdgcn_ds_bpermute((lane ^ 32) << 2, __builtin_bit_cast(int, x))));
        if (kr == 0) atomicMax((unsigned*)(wmax + drow0 + 4 * nq + e), __float_as_uint(x)); }
}
__device__ __forceinline__ void transpose_item_q8(const float* W, int ldw, unsigned char* WT8, int ldt, const float* ks, const float* wmax, LAS float* scr, int k0, int n0, int drow0, int lane, bool s5perm = false) {
    const int nq = lane & 15, kr = lane >> 4;
    f32x4 v[16];
#pragma unroll
    for (int i = 0; i < 16; ++i) v[i] = __builtin_nontemporal_load((const f32x4*)(W + (size_t)(k0 + 4 * i + kr) * ldw + n0 + 4 * nq));
#pragma unroll
    for (int i = 0; i < 16; ++i) v[i] = v[i] * ks[k0 + 4 * i + kr];
#pragma unroll
    for (int i = 0; i < 16; ++i) { LAS float* d = scr + (4 * i + kr) * 65 + 4 * nq; d[0] = v[i][0]; d[1] = v[i][1]; d[2] = v[i][2]; d[3] = v[i][3]; }
    asm volatile("s_waitcnt lgkmcnt(0)" ::: "memory");
#pragma unroll
    for (int j = 0; j < 4; ++j) { const int id = lane + 64 * j, cc = id & 3, n = id >> 2; const LAS float* sp = scr + (16 * cc) * 65 + n;
        const float wm = wmax[drow0 + n], inv = wm > 1e-30f ? 127.0f / wm : 0.f;
        u32x4 o; o.x = pk_i8(sp[0 * 65], sp[1 * 65], sp[2 * 65], sp[3 * 65], inv); o.y = pk_i8(sp[4 * 65], sp[5 * 65], sp[6 * 65], sp[7 * 65], inv);
        o.z = pk_i8(sp[8 * 65], sp[9 * 65], sp[10 * 65], sp[11 * 65], inv); o.w = pk_i8(sp[12 * 65], sp[13 * 65], sp[14 * 65], sp[15 * 65], inv);
        if (s5perm && k0 >= CW) {
            const int kk = k0 - CW + 16 * cc, pos = CW + (kk & 256) + ((kk >> 5) & 3) * 64 + ((kk >> 3) & 3) * 16 + ((kk >> 7) & 1) * 8; unsigned char* rp = WT8 + (size_t)(drow0 + n) * ldt + pos;
            u32x2 lo, hi; lo.x = o.x; lo.y = o.y; hi.x = o.z; hi.y = o.w; *(u32x2*)rp = lo; *(u32x2*)(rp + 16) = hi; }
        else *(u32x4*)(WT8 + (size_t)(drow0 + n) * ldt + k0 + 16 * cc) = o; }
    asm volatile("s_waitcnt lgkmcnt(0)" ::: "memory");
}

struct MoeBase {
    const LAS int* tb; int G, c, T; bool flip = false;
    __device__ __forceinline__ bool locate(int i, eng::Unit& u) const {
        int tile, pn;
        if ((G & 31) == 0) { const int TR = G >> 2, x = flip ? 7 - (c & 7) : (c & 7), j = c >> 3; tile = i * TR + x * (TR >> 3) + (j >> 2); pn = j & 3; }
        else { const long L = (long)i * G + c; tile = (int)(L >> 2); pn = (int)(L & 3); }
        if (tile >= T) return false;
        int ln; asm volatile("v_mbcnt_lo_u32_b32 %0, -1, 0\n\tv_mbcnt_hi_u32_b32 %0, -1, %0" : "=v"(ln));
        const unsigned long long mk = __ballot(ln < NE && tile >= tb[ln & 31]);
        const int e = __builtin_popcountll(mk) - 1; u.e = e; u.pm = __builtin_amdgcn_readfirstlane(tile - tb[e]); u.pn = pn; u.aux = tile; return true;
    }
};
struct MoeGU : MoeBase {
    const unsigned* list;
    __device__ __forceinline__ bool next(int i, eng::Unit& u) const { if (!locate(i, u)) return false; u.ao = 0u; u.bo = ((unsigned)u.e * 1024u + (unsigned)u.pn * 256u) * 1024u; return true; }
    static constexpr bool GATHER = true, WAITS = false, KSKIP = false;
    __device__ __forceinline__ void a_ready(const eng::Unit&, int) const {}
    __device__ __forceinline__ void a_off(const eng::Unit& u, int tid, unsigned (&v)[2][2]) const {
        const int cn = __builtin_amdgcn_readfirstlane(tb[40 + u.e]); const unsigned* le = list + (size_t)u.e * NTOK * 4;
#pragma unroll
        for (int i = 0; i < 2; ++i) { int R, C; eng::stage_rc(tid * 16 + i * 8192, R, C);
#pragma unroll
            for (int h = 0; h < 2; ++h) { int p = u.pm * 256 + h * 128 + R; p = p < cn ? p : cn - 1; const int tok = (int)(le[p * 4] >> 1); v[h][i] = (unsigned)tok * 1024u + (unsigned)C * 2u; } }
    }
};
struct MoeDown : MoeBase {
    unsigned* tc; unsigned* tmo;
    __device__ __forceinline__ bool next(int i, eng::Unit& u) const { if (!locate(i, u)) return false; u.ao = (unsigned)u.aux * 256u * 1024u; u.bo = ((unsigned)u.e * 1024u + (unsigned)u.pn * 256u) * 1024u; return true; }
    __device__ __forceinline__ void a_off(const eng::Unit&, int tid, unsigned (&v)[2][2]) const {
#pragma unroll
        for (int i = 0; i < 2; ++i) { int R, C; eng::stage_rc(tid * 16 + i * 8192, R, C);
#pragma unroll
            for (int h = 0; h < 2; ++h) v[h][i] = (unsigned)(h * 128 + R) * 1024u + (unsigned)C * 2u; } }
    static constexpr bool GATHER = false, WAITS = true, KSKIP = false;
    __device__ __forceinline__ void a_ready(const eng::Unit& u, int tid) const {
        if (tid < 64) {
            unsigned* w = tc + (size_t)u.aux * 64; unsigned sp = 0u;
            while ((unsigned)__builtin_amdgcn_readfirstlane((int)__hip_atomic_load(w, __ATOMIC_RELAXED, __HIP_MEMORY_SCOPE_AGENT)) < 32u) {
                __builtin_amdgcn_s_sleep(2);
                if ((++sp & 255u) == 0u) { if (__hip_atomic_load(tmo, __ATOMIC_RELAXED, __HIP_MEMORY_SCOPE_AGENT) != 0u) break; if (sp > (1u << 22)) { if (tid == 0) __hip_atomic_store(tmo, 1u, __ATOMIC_RELAXED, __HIP_MEMORY_SCOPE_AGENT); break; } } }
            __builtin_amdgcn_fence(__ATOMIC_ACQUIRE, "agent");
            asm volatile("s_waitcnt vmcnt(0)" ::: "memory");
        }
        asm volatile("" ::: "memory"); __builtin_amdgcn_s_barrier(); asm volatile("" ::: "memory");
    }
};
__device__ __forceinline__ float fsigmoid(float x) { return __builtin_amdgcn_rcpf(1.0f + __expf(-x)); }
struct EpiHid {
    static constexpr bool PERM = true, HAS_MID = false, AFTER_DRAIN = false, PUBLISH = true, ONLY_B0 = false, I8 = true;
    h16* HID; const unsigned* list; const LAS int* tb; unsigned* tc; const float* WME;
    __device__ __forceinline__ void operator()(const f32x4 (&acc)[2][2][4][2], const eng::Unit& u, int wr, int wc, int fr, int fq) const {
        f32x4 cw[2][2];
#pragma unroll
        for (int bj = 0; bj < 2; ++bj)
#pragma unroll
            for (int n = 0; n < 2; ++n) cw[bj][n] = *(const f32x4*)(WME + (size_t)u.e * 1024 + u.pn * 256 + bj * 128 + wc * 32 + 8 * fq + 4 * n);
        const int cn = __builtin_amdgcn_readfirstlane(tb[40 + u.e]); const unsigned* le = list + (size_t)u.e * NTOK * 4; const int col0 = u.pn * 128 + wc * 32 + 8 * fq;
        float rr[8];
#pragma unroll
        for (int q = 0; q < 8; ++q) { int p = u.pm * 256 + (q >> 2) * 128 + wr * 64 + (q & 3) * 16 + fr; p = p < cn ? p : cn - 1; const unsigned rb = le[p * 4 + 2]; rr[q] = __uint_as_float(rb); }
#pragma unroll
        for (int ai = 0; ai < 2; ++ai)
#pragma unroll
            for (int m = 0; m < 4; ++m) { const int r = ai * 128 + wr * 64 + m * 16 + fr; const float rs = rr[ai * 4 + m]; float o[8];
#pragma unroll
                for (int n = 0; n < 2; ++n) { const i32x4 ig = __builtin_bit_cast(i32x4, acc[ai][0][m][n]), iu = __builtin_bit_cast(i32x4, acc[ai][1][m][n]);
                    const f32x4 gv = (f32x4){(float)ig[0], (float)ig[1], (float)ig[2], (float)ig[3]} * (cw[0][n] * rs), uv = (f32x4){(float)iu[0], (float)iu[1], (float)iu[2], (float)iu[3]} * (cw[1][n] * rs);
#pragma unroll
                    for (int j = 0; j < 4; ++j) { const float g = gv[j], uu = uv[j]; o[n * 4 + j] = g * fsigmoid(g) * uu; } }
                u32x4 w; w.x = pk_h16(o[0], o[1]); w.y = pk_h16(o[2], o[3]); w.z = pk_h16(o[4], o[5]); w.w = pk_h16(o[6], o[7]);
                asm volatile("global_store_dwordx4 %0, %1, off sc1\n\ts_nop 1" :: "v"((GAS u32x4*)(HID + ((size_t)u.aux * 256 + r) * 512 + col0)), "v"(w) : "memory"); }
    }
    __device__ __forceinline__ void publish(int tile, int lane) const { if (lane == 0) __hip_atomic_fetch_add(tc + (size_t)tile * 64, 1u, __ATOMIC_RELAXED, __HIP_MEMORY_SCOPE_AGENT); }
};
struct EpiScat {
    static constexpr bool PERM = true, HAS_MID = false, AFTER_DRAIN = false, PUBLISH = false, ONLY_B0 = false, I8 = false;
    unsigned char* ys8; float* sc; const unsigned* list; const LAS int* tb;
    __device__ __forceinline__ void operator()(const f32x4 (&acc)[2][2][4][2], const eng::Unit& u, int wr, int wc, int fr, int fq) const {
        const int cn = __builtin_amdgcn_readfirstlane(tb[40 + u.e]); const unsigned* le = list + (size_t)u.e * NTOK * 4; const int col0 = u.pn * 256 + wc * 32 + 8 * fq; const int lane = fr + 16 * fq;
        int ent[8]; float gt[8];
#pragma unroll
        for (int q = 0; q < 8; ++q) { int p = u.pm * 256 + (q >> 2) * 128 + wr * 64 + (q & 3) * 16 + fr; p = p < cn ? p : cn - 1; const u32x2 rc = *(const u32x2*)(le + p * 4); const unsigned r0 = rc[0], r1 = rc[1]; ent[q] = (int)r0; gt[q] = __uint_as_float(r1); }
#pragma unroll
        for (int ai = 0; ai < 2; ++ai)
#pragma unroll
            for (int m = 0; m < 4; ++m) { const int p = u.pm * 256 + ai * 128 + wr * 64 + m * 16 + fr; const float g = gt[ai * 4 + m];
                const f32x4 a0 = acc[ai][0][m][0] * g, b0 = acc[ai][0][m][1] * g, a1 = acc[ai][1][m][0] * g, b1 = acc[ai][1][m][1] * g;
                float am = fmaxf(fmaxf(fmaxf(fabsf(a0[0]), fabsf(a0[1])), fmaxf(fabsf(a0[2]), fabsf(a0[3]))), fmaxf(fmaxf(fabsf(b0[0]), fabsf(b0[1])), fmaxf(fabsf(b0[2]), fabsf(b0[3]))));
                am = fmaxf(am, fmaxf(fmaxf(fmaxf(fabsf(a1[0]), fabsf(a1[1])), fmaxf(fabsf(a1[2]), fabsf(a1[3]))), fmaxf(fmaxf(fabsf(b1[0]), fabsf(b1[1])), fmaxf(fabsf(b1[2]), fabsf(b1[3])))));
                am = fmaxf(am, __builtin_bit_cast(float, __builtin_amdgcn_ds_bpermute((lane ^ 16) << 2, __builtin_bit_cast(int, am))));
                am = fmaxf(am, __builtin_bit_cast(float, __builtin_amdgcn_ds_bpermute((lane ^ 32) << 2, __builtin_bit_cast(int, am))));
                const float inv = am > 1e-30f ? 127.0f / am : 0.f;
                if (p < cn) { unsigned char* rowp = ys8 + (size_t)ent[ai * 4 + m] * DM + u.pn * 256 + wc * 64 + fq * 16;
                    u32x4 w; w.x = pk_u8o(a0[0], a0[1], a0[2], a0[3], inv); w.y = pk_u8o(b0[0], b0[1], b0[2], b0[3], inv); w.z = pk_u8o(a1[0], a1[1], a1[2], a1[3], inv); w.w = pk_u8o(b1[0], b1[1], b1[2], b1[3], inv);
                    __builtin_nontemporal_store(w, (u32x4*)rowp);
                    if (fq == 0) sc[(size_t)ent[ai * 4 + m] * 16 + u.pn * 4 + wc] = am * (1.0f / 127.0f); } }
    }
};

constexpr float SSM_SCALE = 1024.0f, SSM_ISCALE = 1.0f / 1024.0f;
constexpr int TCH = 32, NCH = SEQ / TCH;
__device__ __forceinline__ float gelu_fast(float x) { return x * fsigmoid(1.5957691216057308f * (x + 0.044715f * x * x * x)); }
struct EpiIn {
    static constexpr bool PERM = true, HAS_MID = false, AFTER_DRAIN = false, PUBLISH = false, ONLY_B0 = false, I8 = true;
    h16* U; h16* SG; const float* RR0; const float* WMAX;
    __device__ __forceinline__ void operator()(const f32x4 (&acci)[2][2][4][2], const eng::Unit& u, int wr, int wc, int fr, int fq) const {
        float rr[8];
#pragma unroll
        for (int q = 0; q < 8; ++q) rr[q] = RR0[u.pm * 256 + (q >> 2) * 128 + wr * 64 + (q & 3) * 16 + fr];
        f32x4 cw[2][2];
#pragma unroll
        for (int bj = 0; bj < 2; ++bj)
#pragma unroll
            for (int n = 0; n < 2; ++n) cw[bj][n] = *(const f32x4*)(WMAX + u.pn * 256 + bj * 128 + wc * 32 + 8 * fq + 4 * n);
#define EI_CV(ai, bj, m, n) ({ const i32x4 iv_ = __builtin_bit_cast(i32x4, acci[ai][bj][m][n]); (f32x4){(float)iv_[0], (float)iv_[1], (float)iv_[2], (float)iv_[3]} * cw[bj][n]; })
        if (u.pn < 4) {
            const int col0 = u.pn * 128 + wc * 32 + 8 * fq;
#pragma unroll
            for (int ai = 0; ai < 2; ++ai)
#pragma unroll
                for (int m = 0; m < 4; ++m) { const int tok = u.pm * 256 + ai * 128 + wr * 64 + m * 16 + fr; const float rs = rr[ai * 4 + m]; float o[8];
#pragma unroll
                    for (int n = 0; n < 2; ++n) { const f32x4 va = EI_CV(ai, 0, m, n), ga = EI_CV(ai, 1, m, n);
#pragma unroll
                        for (int j = 0; j < 4; ++j) o[n * 4 + j] = va[j] * rs * fsigmoid(ga[j] * rs); }
                    u32x4 w; w.x = pk_h16(o[0], o[1]); w.y = pk_h16(o[2], o[3]); w.z = pk_h16(o[4], o[5]); w.w = pk_h16(o[6], o[7]);
                    *(u32x4*)(U + (size_t)tok * CW + col0) = w; }
        } else {
#pragma unroll
            for (int bj = 0; bj < 2; ++bj) { const int ch = (u.pn - 4) * 256 + bj * 128 + wc * 32 + 8 * fq, g = ch >> 4, c0 = ch & 15;
#pragma unroll
                for (int ai = 0; ai < 2; ++ai)
#pragma unroll
                    for (int m = 0; m < 4; ++m) { const int tok = u.pm * 256 + ai * 128 + wr * 64 + m * 16 + fr; const f32x4 a = EI_CV(ai, bj, m, 0) * rr[ai * 4 + m], b = EI_CV(ai, bj, m, 1) * rr[ai * 4 + m];
                        u32x4 w; w.x = pk_h16(a[0], a[1]); w.y = pk_h16(a[2], a[3]); w.z = pk_h16(b[0], b[1]); w.w = pk_h16(b[2], b[3]);
                        *(u32x4*)(SG + ((size_t)g * 1024 + (tok >> 5)) * 640 + (tok & 31) * 16 + c0) = w; } }
        }
#undef EI_CV
    }
};
struct SsmSOrder {
    int G, c;
    static __device__ __forceinline__ int unit_of(int G, int c) { if (G == 256) return (c >> 3) < 16 ? (c & 7) * 16 + (c >> 3) : -1; return c < NG * 4 ? c : -1; }
    __device__ __forceinline__ bool next(int i, eng::Unit& u) const {
        const int L = unit_of(G, c); if (i > 0 || L < 0) return false;
        u.e = L >> 2; u.pm = L & 3; u.pn = 0; u.aux = 0; u.ao = ((unsigned)u.e * 1024u + (unsigned)u.pm * 256u) * 1280u; u.bo = (unsigned)u.e * 256u * 1024u; return true; }
    __device__ __forceinline__ void a_off(const eng::Unit&, int tid, unsigned (&v)[2][2]) const {
#pragma unroll
        for (int i = 0; i < 2; ++i) { int R, C; eng::stage_rc(tid * 16 + i * 8192, R, C);
#pragma unroll
            for (int h = 0; h < 2; ++h) v[h][i] = (unsigned)(h * 128 + R) * 1280u + (unsigned)C * 2u; } }
    static constexpr bool GATHER = false, WAITS = false, KSKIP = false;
    __device__ __forceinline__ void a_ready(const eng::Unit&, int) const {}
};
struct EpiS {
    static constexpr bool PERM = false, HAS_MID = false, AFTER_DRAIN = true, PUBLISH = false, ONLY_B0 = true, I8 = false;
    h16* SG; const float* AT;
    __device__ __forceinline__ void operator()(const f32x4 (&)[2][2][4][2], const eng::Unit&, int, int, int, int) const {}
    __device__ __forceinline__ void fused(const f32x4 (&acc)[2][2][4][2], const eng::Unit& u, LAS unsigned char* lds, int tid, int wr, int wc, int fr, int fq) const {
        LAS float* Sl = (LAS float*)lds;
#pragma unroll
        for (int ai = 0; ai < 2; ++ai)
#pragma unroll
            for (int m = 0; m < 4; ++m)
#pragma unroll
                for (int n = 0; n < 2; ++n) *(LAS f32x4*)(Sl + (ai * 128 + wr * 64 + m * 16 + fr) * 132 + wc * 32 + n * 16 + 4 * fq) = acc[ai][0][m][n] * SSM_ISCALE;
        __syncthreads();
        if (tid < 256) { const int bl = tid >> 6, n = tid & 63; const float are = AT[(u.e * NS + n) * 2], aim = AT[(u.e * NS + n) * 2 + 1]; float hr = 0.f, hi2 = 0.f;
            h16* sg = SG + ((size_t)u.e * 1024 + u.pm * 256 + bl * 64) * 640;
#pragma unroll 8
            for (int j = 0; j < NCH; ++j) { sg[(size_t)j * 640 + 512 + n] = (h16)hr; sg[(size_t)j * 640 + 576 + n] = (h16)hi2;
                const float sr = Sl[(bl * 64 + j) * 132 + n], si = Sl[(bl * 64 + j) * 132 + 64 + n]; const float nr = are * hr - aim * hi2 + sr, ni = are * hi2 + aim * hr + si; hr = nr; hi2 = ni; } }
        asm volatile("s_waitcnt vmcnt(0)" ::: "memory");
        __syncthreads();
    }
};
struct SsmYOrder {
    int G, c;
    __device__ __forceinline__ bool next(int i, eng::Unit& u) const {
        const int L = i * G + ((G & 7) == 0 ? (c & 7) * (G >> 3) + (c >> 3) : c); if (L >= NG * 8) return false;
        u.e = L >> 3; u.pm = (L >> 1) & 3; u.pn = L & 1; u.aux = 0; u.ao = ((unsigned)u.e * 1024u + (unsigned)u.pm * 256u) * 1280u; u.bo = ((unsigned)u.e * 512u + (unsigned)u.pn * 256u) * 1280u; return true; }
    __device__ __forceinline__ void a_off(const eng::Unit&, int tid, unsigned (&v)[2][2]) const {
#pragma unroll
        for (int i = 0; i < 2; ++i) { int R, C; eng::stage_rc(tid * 16 + i * 8192, R, C);
#pragma unroll
            for (int h = 0; h < 2; ++h) v[h][i] = (unsigned)(h * 128 + R) * 1280u + (unsigned)C * 2u; } }
    static constexpr bool GATHER = false, WAITS = false, KSKIP = false;
    __device__ __forceinline__ void a_ready(const eng::Unit&, int) const {}
};
struct SsmYLocal : SsmYOrder {
    __device__ __forceinline__ bool next(int i, eng::Unit& u) const {
        const int L = SsmSOrder::unit_of(G, c); if (i > 1 || L < 0) return false;
        u.e = L >> 2; u.pm = L & 3; u.pn = i; u.aux = 0; u.ao = ((unsigned)u.e * 1024u + (unsigned)u.pm * 256u) * 1280u; u.bo = ((unsigned)u.e * 512u + (unsigned)u.pn * 256u) * 1280u;
        u.nt = i == 0 ? 6 : 10; u.kcut = i == 0 ? 4 : 1 << 20; u.kskip = i == 0 ? 4 : 0; return true; }
    static constexpr bool KSKIP = true;
};
struct EpiY {
    static constexpr bool PERM = true, HAS_MID = false, AFTER_DRAIN = false, PUBLISH = false, ONLY_B0 = false, I8 = false;
    const h16* SG; const float* dco; h16* VG;
    __device__ __forceinline__ void operator()(const f32x4 (&acc)[2][2][4][2], const eng::Unit& u, int wr, int wc, int fr, int fq) const {
#pragma unroll
        for (int bj = 0; bj < 2; ++bj) { const int col0 = u.pn * 256 + bj * 128 + wc * 32 + 8 * fq, c0 = col0 & 15;
            const f32x4 d0 = *(const f32x4*)(dco + u.e * 16 + c0), d1 = *(const f32x4*)(dco + u.e * 16 + c0 + 4);
            h16x8 uv[8];
#pragma unroll
            for (int q = 0; q < 8; ++q) uv[q] = *(const h16x8*)(SG + ((size_t)u.e * 1024 + u.pm * 256 + (q >> 2) * 128 + wr * 64 + (q & 3) * 16 + fr) * 640 + col0);
#pragma unroll
            for (int ai = 0; ai < 2; ++ai)
#pragma unroll
                for (int m = 0; m < 4; ++m) { const int row = u.pm * 256 + ai * 128 + wr * 64 + m * 16 + fr; const h16x8 x = uv[ai * 4 + m];
                    float o[8];
#pragma unroll
                    for (int j = 0; j < 4; ++j) { o[j] = gelu_fast(acc[ai][bj][m][0][j] * SSM_ISCALE + d0[j] * (float)x[j]); o[4 + j] = gelu_fast(acc[ai][bj][m][1][j] * SSM_ISCALE + d1[j] * (float)x[4 + j]); }
                    u32x4 w; w.x = pk_h16(o[0], o[1]); w.y = pk_h16(o[2], o[3]); w.z = pk_h16(o[4], o[5]); w.w = pk_h16(o[6], o[7]);
                    *(u32x4*)(VG + ((size_t)u.e * 1024 + row) * 512 + col0) = w; } }
    }
};
struct GluOrder : eng::DenseOrder {
    static constexpr bool GATHER = false, WAITS = false, KSKIP = false;
    __device__ __forceinline__ void a_ready(const eng::Unit&, int) const {}
    __device__ __forceinline__ bool next(int i, eng::Unit& u) const { if (!eng::DenseOrder::next(i, u)) return false; u.ao = (unsigned)u.pm * 256u * 32u; return true; }
    __device__ __forceinline__ void a_off(const eng::Unit&, int tid, unsigned (&v)[2][2]) const {
#pragma unroll
        for (int i = 0; i < 2; ++i) { int R, C; eng::stage_rc(tid * 16 + i * 8192, R, C);
#pragma unroll
            for (int h = 0; h < 2; ++h) v[h][i] = (unsigned)(h * 128 + R) * 32u + (unsigned)(C >> 4) * (unsigned)(NTOK * 32) + (unsigned)(C & 15) * 2u; } }
};
__device__ __forceinline__ float xor_add(float v, int lane, int m) { return v + __builtin_bit_cast(float, __builtin_amdgcn_ds_bpermute((lane ^ m) << 2, __builtin_bit_cast(int, v))); }
struct EpiGlu {
    static constexpr bool PERM = true, HAS_MID = false, AFTER_DRAIN = false, PUBLISH = false, ONLY_B0 = false, I8 = false;
    const h16* VG; const float* bias; unsigned char* YH8; float* SSQ2; float* SIGS; LAS unsigned char* lds;
    __device__ __forceinline__ void operator()(const f32x4 (&acc)[2][2][4][2], const eng::Unit& u, int wr, int wc, int fr, int fq) const {
        const int lane = fr + 16 * fq; LAS float* sx = (LAS float*)(lds + 131584);
        f32x4 bv[2][2];
#pragma unroll
        for (int bj = 0; bj < 2; ++bj)
#pragma unroll
            for (int n = 0; n < 2; ++n) bv[bj][n] = *(const f32x4*)(bias + u.pn * 256 + bj * 128 + wc * 32 + 8 * fq + 4 * n);
        unsigned yh[2][4][8];
#pragma unroll
        for (int ai = 0; ai < 2; ++ai) {
            h16x8 vv[4][2];
#pragma unroll
            for (int m = 0; m < 4; ++m)
#pragma unroll
                for (int bj = 0; bj < 2; ++bj) { const int tok = u.pm * 256 + ai * 128 + wr * 64 + m * 16 + fr, ch0 = u.pn * 256 + bj * 128 + wc * 32 + 8 * fq;
                    vv[m][bj] = *(const h16x8*)(VG + (size_t)(ch0 >> 4) * (NTOK * 16) + (size_t)tok * 16 + (ch0 & 15)); }
#pragma unroll
            for (int m = 0; m < 4; ++m) { const int tok = u.pm * 256 + ai * 128 + wr * 64 + m * 16 + fr; float ss = 0.f, am = 0.f;
#pragma unroll
                for (int bj = 0; bj < 2; ++bj) { float o[8];
#pragma unroll
                    for (int n = 0; n < 2; ++n)
#pragma unroll
                        for (int j = 0; j < 4; ++j) { const float y = (float)vv[m][bj][n * 4 + j] * fsigmoid(acc[ai][bj][m][n][j] + bv[bj][n][j]); o[n * 4 + j] = y; ss += y * y; am = fmaxf(am, fabsf(y)); }
                    yh[ai][m][bj * 4 + 0] = pk_h16(o[0], o[1]); yh[ai][m][bj * 4 + 1] = pk_h16(o[2], o[3]); yh[ai][m][bj * 4 + 2] = pk_h16(o[4], o[5]); yh[ai][m][bj * 4 + 3] = pk_h16(o[6], o[7]); }
                ss = xor_add(ss, lane, 16); ss = xor_add(ss, lane, 32);
                am = fmaxf(am, __builtin_bit_cast(float, __builtin_amdgcn_ds_bpermute((lane ^ 16) << 2, __builtin_bit_cast(int, am))));
                am = fmaxf(am, __builtin_bit_cast(float, __builtin_amdgcn_ds_bpermute((lane ^ 32) << 2, __builtin_bit_cast(int, am))));
                if (fq == 0) { SSQ2[(size_t)tok * 8 + u.pn * 4 + wc] = ss; sx[(ai * 128 + wr * 64 + m * 16 + fr) * 4 + wc] = am; } } }
        asm volatile("s_waitcnt lgkmcnt(0)" ::: "memory"); __builtin_amdgcn_s_barrier(); asm volatile("" ::: "memory");
#pragma unroll
        for (int ai = 0; ai < 2; ++ai)
#pragma unroll
            for (int m = 0; m < 4; ++m) { const int r = ai * 128 + wr * 64 + m * 16 + fr, tok = u.pm * 256 + r; const f32x4 s4 = *(const LAS f32x4*)(sx + r * 4);
                const float rm = fmaxf(fmaxf(s4[0], s4[1]), fmaxf(s4[2], s4[3])), inv = rm > 1e-30f ? 127.0f / rm : 0.f; u32x4 w;
#pragma unroll
                for (int d = 0; d < 4; ++d) { const unsigned p0 = yh[ai][m][2 * d], p1 = yh[ai][m][2 * d + 1]; const h16x2 h0 = __builtin_bit_cast(h16x2, p0), h1 = __builtin_bit_cast(h16x2, p1);
                    const unsigned qd = pk_i8((float)h0[0], (float)h0[1], (float)h1[0], (float)h1[1], inv); if (d == 0) w.x = qd; else if (d == 1) w.y = qd; else if (d == 2) w.z = qd; else w.w = qd; }
                *(u32x4*)(YH8 + (size_t)tok * DM + CW + u.pn * 256 + wc * 64 + fq * 16) = w;
                if (wc == 0 && fq == 0) SIGS[(size_t)tok * 2 + u.pn] = rm * (1.0f / 127.0f); }
    }
};
struct EpiOut {
    static constexpr bool PERM = true, HAS_MID = true, AFTER_DRAIN = false, PUBLISH = false, ONLY_B0 = false, I8 = true;
    const h16* src; h16* dst; float* SSQ1; const float* WMAXO; LAS unsigned char* lds;
    __device__ __forceinline__ void mid(f32x4 (&acc)[2][2][4][2], const eng::Unit& u, int wr, int wc, int fr, int fq, int ui, int which) const {
        const LAS float* fac = (const LAS float*)(lds + 131584) + (size_t)(ui & 1) * 1024;
#pragma unroll
        for (int ai = 0; ai < 2; ++ai)
#pragma unroll
            for (int m = 0; m < 4; ++m) { const float rho = fac[(ai * 128 + wr * 64 + m * 16 + fr) * 4 + which];
#pragma unroll
                for (int bj = 0; bj < 2; ++bj)
#pragma unroll
                    for (int n = 0; n < 2; ++n) { const i32x4 iv = __builtin_bit_cast(i32x4, acc[ai][bj][m][n]);
                        const i32x4 ov = {(int)((float)iv[0] * rho), (int)((float)iv[1] * rho), (int)((float)iv[2] * rho), (int)((float)iv[3] * rho)};
                        acc[ai][bj][m][n] = __builtin_bit_cast(f32x4, ov); } }
    }
    __device__ __forceinline__ void operator()(const f32x4 (&acc)[2][2][4][2], const eng::Unit& u, int wr, int wc, int fr, int fq, int ui) const {
        const int lane = fr + 16 * fq; const int row0 = u.pm * 256 + wr * 64 + fr, col0 = u.pn * 256 + wc * 32 + 8 * fq;
        const LAS float* fac = (const LAS float*)(lds + 131584) + (size_t)(ui & 1) * 1024;
        h16x8 cwh[2];
#pragma unroll
        for (int bj = 0; bj < 2; ++bj) { const f32x4 c0 = *(const f32x4*)(WMAXO + col0 + bj * 128), c1 = *(const f32x4*)(WMAXO + col0 + bj * 128 + 4);
            cwh[bj] = (h16x8){(h16)c0[0], (h16)c0[1], (h16)c0[2], (h16)c0[3], (h16)c1[0], (h16)c1[1], (h16)c1[2], (h16)c1[3]}; }
#pragma unroll
        for (int ai = 0; ai < 2; ++ai) {
            h16x8 xs[4][2];
#pragma unroll
            for (int m = 0; m < 4; ++m) { const size_t o = (size_t)(row0 + ai * 128 + m * 16) * DM + col0;
#pragma unroll
                for (int bj = 0; bj < 2; ++bj) xs[m][bj] = *(const h16x8*)(src + o + bj * 128); }
#pragma unroll
            for (int m = 0; m < 4; ++m) { const int row = row0 + ai * 128 + m * 16; const size_t o = (size_t)row * DM + col0; float ss = 0.f, am = 0.f;
                const float rf = fac[(ai * 128 + wr * 64 + m * 16 + fr) * 4 + 2];
#pragma unroll
                for (int bj = 0; bj < 2; ++bj) { h16x8 hv;
#pragma unroll
                    for (int n = 0; n < 2; ++n) { const i32x4 iv = __builtin_bit_cast(i32x4, acc[ai][bj][m][n]); const f32x4 dv = (f32x4){(float)iv[0] * (float)cwh[bj][n * 4], (float)iv[1] * (float)cwh[bj][n * 4 + 1], (float)iv[2] * (float)cwh[bj][n * 4 + 2], (float)iv[3] * (float)cwh[bj][n * 4 + 3]} * rf;
#pragma unroll
                        for (int j = 0; j < 4; ++j) { const h16 h = (h16)((float)xs[m][bj][n * 4 + j] + dv[j]); hv[n * 4 + j] = h; const float f = (float)h; ss += f * f; am = fmaxf(am, fabsf(f)); } }
                    *(h16x8*)(dst + o + bj * 128) = hv; }
                ss = xor_add(ss, lane, 16); ss = xor_add(ss, lane, 32);
                am = fmaxf(am, __builtin_bit_cast(float, __builtin_amdgcn_ds_bpermute((lane ^ 16) << 2, __builtin_bit_cast(int, am))));
                am = fmaxf(am, __builtin_bit_cast(float, __builtin_amdgcn_ds_bpermute((lane ^ 32) << 2, __builtin_bit_cast(int, am))));
                if (fq == 0) { u32x2 pr; pr.x = __float_as_uint(ss); pr.y = __float_as_uint(am); *(u32x2*)(SSQ1 + ((size_t)row * 16 + u.pn * 4 + wc) * 2) = pr; } } }
    }
};
__device__ __forceinline__ void ssm_tables(const float* const* in, int l, int g, int p, h16* BSt, h16* MYt, float* AT, LAS float* tbl, int tid) {
    LAS float* PW = tbl;
    LAS float* BB = tbl + 4224;
    LAS float* CC = tbl + 6272;
    LAS float* KT = tbl + 6528;
    const float dt = expf(in[9][l * NG + g]);
    __syncthreads();
    if (tid < NS) { const int n = tid; const float lr = in[7][(l * NG + g) * NS + n], li = in[8][(l * NG + g) * NS + n];
        const float mag = expf(lr * dt), are = mag * __cosf(li * dt), aim = mag * __sinf(li * dt); float pr = 1.f, pi = 0.f; asm volatile("" : "+v"(pr), "+v"(pi));
        for (int d = 0; d <= TCH; ++d) { PW[(n * 33 + d) * 2] = pr; PW[(n * 33 + d) * 2 + 1] = pi; const float nr = pr * are - pi * aim, ni = pr * aim + pi * are; pr = nr; pi = ni; } }
    for (int idx = tid; idx < NS * SGC; idx += NTHREADS) { const int n = idx >> 4, cc = idx & 15; const float lr = in[7][(l * NG + g) * NS + n], li = in[8][(l * NG + g) * NS + n];
        const float x = lr * dt, y = li * dt, cy = __cosf(y), sy = __sinf(y), sh = __sinf(0.5f * y), nr = expm1f(x) * cy - 2.f * sh * sh, aim = expf(x) * sy, den = lr * lr + li * li;
        const float qre = (nr * lr + aim * li) / den, qim = (aim * lr - nr * li) / den;
        const float br = in[10][((size_t)(l * NG + g) * NS + n) * SGC + cc], bi = in[11][((size_t)(l * NG + g) * NS + n) * SGC + cc];
        BB[idx * 2] = qre * br - qim * bi; BB[idx * 2 + 1] = qre * bi + qim * br; }
    for (int idx = tid; idx < 2 * NS; idx += NTHREADS) { const int cl = idx >> 6, n = idx & 63, co = 2 * p + cl;
        CC[idx * 2] = in[12][((size_t)(l * NG + g) * SGC + co) * NS + n]; CC[idx * 2 + 1] = in[13][((size_t)(l * NG + g) * SGC + co) * NS + n]; }
    __syncthreads();
    for (int idx = tid; idx < 32 * 2 * 16; idx += NTHREADS) { const int d = idx >> 5, cl = (idx >> 4) & 1, ci = idx & 15; float s = 0.f;
        for (int n = 0; n < NS; ++n) { const float cr = CC[(cl * 64 + n) * 2], cim = CC[(cl * 64 + n) * 2 + 1], pr = PW[(n * 33 + d) * 2], pi = PW[(n * 33 + d) * 2 + 1], br = BB[(n * 16 + ci) * 2], bi = BB[(n * 16 + ci) * 2 + 1];
            const float xr = cr * pr - cim * pi, xi = cr * pi + cim * pr; s += xr * br - xi * bi; }
        KT[idx] = s; }
    __syncthreads();
    for (int idx = tid; idx < 64 * 80; idx += NTHREADS) { const int rl = idx / 80, q = idx % 80, t = rl >> 1, cl = rl & 1, co = 2 * p + cl; float o[8];
        if (q < 64) { const int s = q >> 1, ci0 = (q & 1) * 8;
#pragma unroll
            for (int j = 0; j < 8; ++j) o[j] = (s <= t) ? KT[((t - s) * 2 + cl) * 16 + ci0 + j] * SSM_SCALE : 0.f; }
        else { const int im = (q >= 72), n0 = (q - 64 - 8 * im) * 8;
#pragma unroll
            for (int j = 0; j < 8; ++j) { const int n = n0 + j; const float cr = CC[(cl * 64 + n) * 2], cim = CC[(cl * 64 + n) * 2 + 1], pr = PW[(n * 33 + t + 1) * 2], pi = PW[(n * 33 + t + 1) * 2 + 1];
                o[j] = (im ? -(cr * pi + cim * pr) : (cr * pr - cim * pi)) * SSM_SCALE; } }
        u32x4 w; w.x = pk_h16(o[0], o[1]); w.y = pk_h16(o[2], o[3]); w.z = pk_h16(o[4], o[5]); w.w = pk_h16(o[6], o[7]);
        *(u32x4*)(MYt + ((size_t)g * 512 + t * 16 + co) * 640 + q * 8) = w; }
    for (int idx = tid; idx < 32 * 64; idx += NTHREADS) { const int rl = idx >> 6, q = idx & 63, s = q >> 1, c0 = (q & 1) * 8; float o[8]; int row;
        if (rl < 16) { const int im = rl >> 3, n = 8 * p + (rl & 7); row = im * 64 + n; const float pr = PW[(n * 33 + (TCH - 1 - s)) * 2], pi = PW[(n * 33 + (TCH - 1 - s)) * 2 + 1];
#pragma unroll
            for (int j = 0; j < 8; ++j) { const float br = BB[(n * 16 + c0 + j) * 2], bi = BB[(n * 16 + c0 + j) * 2 + 1]; o[j] = (im ? (pr * bi + pi * br) : (pr * br - pi * bi)) * SSM_SCALE; } }
        else { row = 128 + 16 * p + (rl - 16);
#pragma unroll
            for (int j = 0; j < 8; ++j) o[j] = 0.f; }
        u32x4 w; w.x = pk_h16(o[0], o[1]); w.y = pk_h16(o[2], o[3]); w.z = pk_h16(o[4], o[5]); w.w = pk_h16(o[6], o[7]);
        *(u32x4*)(BSt + ((size_t)g * 256 + row) * 512 + q * 8) = w; }
    if (p == 0 && tid < NS) { AT[(g * NS + tid) * 2] = PW[(tid * 33 + TCH) * 2]; AT[(g * NS + tid) * 2 + 1] = PW[(tid * 33 + TCH) * 2 + 1]; }
    __syncthreads();
}

struct Args { const float* in[28]; float* out; unsigned char* ws; int ph_lo, ph_hi; };

constexpr int PPL = 12;
constexpr int NPH = DEPTH * PPL;

struct Ctx { const float* const* in; float* out; GAS unsigned char* ws; LAS unsigned char* lds; int l, G, bid, probe, wv; };
#define OPQ() int tid = c.wv * 64 + lane_id_(); asm volatile("" : "+v"(tid)); const int lane = tid & 63, wave = __builtin_amdgcn_readfirstlane(tid >> 6); (void)lane; (void)wave
#define WSP(T, off) ((T*)(GAS T*)(c.ws + (off)))

__device__ __forceinline__ void ph_norm_in(const Ctx& c) {
    OPQ(); h16* X16 = WSP(h16, WS_HH); float* RR0 = WSP(float, WS_RR0); const float* xsrc = c.in[0]; unsigned* X8 = WSP(unsigned, WS_X8);
    for (int row = c.bid * NWAVES + wave; row < NTOK; row += c.G * NWAVES) {
        const f32x4* xr = (const f32x4*)(xsrc + (size_t)row * DM) + lane; float s = 0.f, am = 0.f; u32x2* hr = (u32x2*)(X16 + (size_t)row * DM) + lane; f32x4 fv[4];
#pragma unroll
        for (int j = 0; j < 4; ++j) { const f32x4 v = __builtin_nontemporal_load(xr + 64 * j); h16x4 h;
#pragma unroll
            for (int e = 0; e < 4; ++e) { h[e] = (h16)v[e]; const float f = (float)h[e]; fv[j][e] = f; s += f * f; am = fmaxf(am, fabsf(f)); }
            hr[64 * j] = __builtin_bit_cast(u32x2, h); }
        const float r = 1.0f / sqrtf(wave_sum(s, lane) * (1.0f / DM) + eps_());
        am = wave_max(am, lane); const float inv = am > 1e-30f ? 127.0f / am : 0.f;
#pragma unroll
        for (int j = 0; j < 4; ++j) X8[(size_t)row * (DM / 4) + lane + 64 * j] = pk_i8(fv[j][0], fv[j][1], fv[j][2], fv[j][3], inv);
        if (lane == 0) RR0[row] = r * am * (1.0f / (127.0f * 127.0f));
    }
}
__device__ __forceinline__ void ph_tables(const Ctx& c) {
    OPQ();
    for (int it = c.bid; it < NG * 8; it += c.G) ssm_tables(c.in, c.l, it >> 3, it & 7, WSP(h16, WS_BS), WSP(h16, WS_MY), WSP(float, WS_AT), (LAS float*)c.lds, tid);
    { const int l = c.l; h16* WRf = WSP(h16, WS_WR); const float* gf = c.in[19] + l * DM; const float* wrg = c.in[20] + (size_t)l * DM * MG; const float* wre = c.in[22] + (size_t)l * DM * NE;
      for (int idx = c.bid * NTHREADS + tid; idx < 32 * 3 * 2 * 64; idx += c.G * NTHREADS) { const int ln = idx & 63, hl = (idx >> 6) & 1, nb = (idx >> 7) % 3, kk = (idx >> 7) / 3, n = nb * 16 + (ln & 15); float o[8];
#pragma unroll
          for (int j = 0; j < 8; ++j) { const int k = (kk >> 2) * 128 + (ln >> 4) * 32 + (kk & 3) * 8 + j;     float w = n < MG ? wrg[(size_t)k * MG + n] : (n < MG + NE ? wre[(size_t)k * NE + n - MG] : 0.f); w *= gf[k];
              const float hi = (float)(h16)w; o[j] = hl ? (w - hi) : hi; }
          u32x4 wv; wv.x = pk_h16(o[0], o[1]); wv.y = pk_h16(o[2], o[3]); wv.z = pk_h16(o[4], o[5]); wv.w = pk_h16(o[6], o[7]);
          *(u32x4*)(WRf + (size_t)idx * 8) = wv; } }
}
constexpr int I_D = (DE / 64) * (DM / 64), NITE = NE * I_D;
constexpr int NSTRIP = NE * 2 * (DE / 64);
#define WGU_SET(l) ((l) & 1 ? WSP(h16, WS_W2) : WSP(h16, WS_WGU))
#define WD_SET(l)  ((l) & 1 ? WSP(h16, WS_W2 + 64 * MiB) : WSP(h16, WS_WD))
__device__ __forceinline__ void expert_item(const Ctx& c, int lw, int it, LAS float* scr, int lane) {
    h16* WdT = WD_SET(lw);
    const int e = it / I_D, r = it - e * I_D, kb = r / (DM / 64), nb = r % (DM / 64);
    transpose_item(c.in[26] + ((size_t)lw * NE + e) * DE * DM, DM, WdT + (size_t)e * 1024 * 512, DE, nullptr, scr, kb * 64, nb * 64, nb * 64, lane);
}
__device__ __forceinline__ void ph_wstrips(const Ctx& c) {
    OPQ(); const int l = c.l; unsigned char* W8 = WSP(unsigned char, WS_WGU8); float* WME = WSP(float, WS_WME) + (size_t)l * NE * 1024; const float* ks = c.in[19] + l * DM;
    LAS unsigned char* T = c.lds + wave * 8192; LAS float* mx = (LAS float*)(c.lds + 65536);
    const int nq = lane & 15, kr = lane >> 4;
    for (int it = c.bid; it < NSTRIP; it += c.G) {
        const int e = it >> 4, up = (it >> 3) & 1, n0 = (it & 7) * 64, drow0 = 256 * (n0 >> 7) + 128 * up + (n0 & 127);
        const int k0 = wave * 128 + kr * 32;
        const float* W = (up ? c.in[25] : c.in[24]) + ((size_t)l * NE + e) * DM * DE + n0 + 4 * nq + (size_t)k0 * DE; asm volatile("" : "+v"(W));
        f32x4 v[32];
#pragma unroll
        for (int i = 0; i < 32; ++i) v[i] = __builtin_nontemporal_load((const f32x4*)(W + (size_t)i * DE));
        f32x4 m = {0.f, 0.f, 0.f, 0.f};
#pragma unroll
        for (int i = 0; i < 32; ++i) { v[i] = v[i] * ks[k0 + i];
#pragma unroll
            for (int e4 = 0; e4 < 4; ++e4) m[e4] = fmaxf(m[e4], fabsf(v[i][e4])); }
#pragma unroll
        for (int e4 = 0; e4 < 4; ++e4) { float x = m[e4];
            x = fmaxf(x, __builtin_bit_cast(float, __builtin_amdgcn_ds_bpermute((lane ^ 16) << 2, __builtin_bit_cast(int, x))));
            x = fmaxf(x, __builtin_bit_cast(float, __builtin_amdgcn_ds_bpermute((lane ^ 32) << 2, __builtin_bit_cast(int, x)))); m[e4] = x; }
        __syncthreads();
        if (kr == 0) *(LAS f32x4*)(mx + wave * 64 + 4 * nq) = m;
        __syncthreads();
        f32x4 cm = *(const LAS f32x4*)(mx + 4 * nq);
#pragma unroll
        for (int w = 1; w < NWAVES; ++w) { const f32x4 o = *(const LAS f32x4*)(mx + w * 64 + 4 * nq);
#pragma unroll
            for (int e4 = 0; e4 < 4; ++e4) cm[e4] = fmaxf(cm[e4], o[e4]); }
        if (wave == 0 && kr == 0) *(f32x4*)(WME + (size_t)e * 1024 + drow0 + 4 * nq) = cm;
#pragma unroll
        for (int e4 = 0; e4 < 4; ++e4) { const float inv = cm[e4] > 1e-30f ? 127.0f / cm[e4] : 0.f; u32x4 w0, w1;
            w0.x = pk_i8(v[0][e4], v[1][e4], v[2][e4], v[3][e4], inv); w0.y = pk_i8(v[4][e4], v[5][e4], v[6][e4], v[7][e4], inv); w0.z = pk_i8(v[8][e4], v[9][e4], v[10][e4], v[11][e4], inv); w0.w = pk_i8(v[12][e4], v[13][e4], v[14][e4], v[15][e4], inv);
            w1.x = pk_i8(v[16][e4], v[17][e4], v[18][e4], v[19][e4], inv); w1.y = pk_i8(v[20][e4], v[21][e4], v[22][e4], v[23][e4], inv); w1.z = pk_i8(v[24][e4], v[25][e4], v[26][e4], v[27][e4], inv); w1.w = pk_i8(v[28][e4], v[29][e4], v[30][e4], v[31][e4], inv);
            LAS u32x4* tp = (LAS u32x4*)(T + (4 * nq + e4) * 128 + kr * 32); tp[0] = w0; tp[1] = w1; }
        asm volatile("s_waitcnt lgkmcnt(0)" ::: "memory");
#pragma unroll
        for (int j = 0; j < 8; ++j) { const int id = lane + 64 * j, n = id >> 3, ch = id & 7; const u32x4 o = *(const LAS u32x4*)(T + n * 128 + ch * 16);
            __builtin_nontemporal_store(o, (u32x4*)(W8 + ((size_t)e * 1024 + drow0 + n) * DM + wave * 128 + ch * 16)); }
        asm volatile("s_waitcnt lgkmcnt(0)" ::: "memory");
    }
    __syncthreads();
}
__device__ __forceinline__ void ph_wmax(const Ctx& c) {
    OPQ(); constexpr int I_IN = (DM / 64) * (INW / 64);
    const int gw = c.bid * NWAVES + wave, NGW = c.G * NWAVES;
    constexpr int I_OUT = (DM / 64) * (DM / 64);
    for (int it = gw; it < DEPTH * (I_IN + I_OUT); it += NGW) { const int l = it / (I_IN + I_OUT); int r = it % (I_IN + I_OUT);
        if (r < I_IN) { const int kb = r / (INW / 64), nb = r % (INW / 64), n0 = nb * 64;
            const int dr = n0 < CW ? 256 * (n0 >> 7) + (n0 & 127) : (n0 < 2 * CW ? 256 * ((n0 - CW) >> 7) + 128 + ((n0 - CW) & 127) : n0);
            absmax_item(c.in[2] + (size_t)l * DM * INW, INW, c.in[1] + l * DM, WSP(float, WS_WMAX) + l * INW, kb * 64, n0, dr, lane); }
        else { r -= I_IN; const int kb = r / (DM / 64), nb = r % (DM / 64); absmax_item(c.in[18] + (size_t)l * DM * DM, DM, c.in[17] + l * DM, WSP(float, WS_WMAXO) + l * DM, kb * 64, nb * 64, nb * 64, lane); } }
}
__device__ __forceinline__ void ph_weights(const Ctx& c) {
    OPQ(); const int l = c.l;
    h16* WinT = WSP(h16, WS_WIN); h16* GluT = WSP(h16, WS_GLU); h16* WoutT = WSP(h16, WS_WOUT);
    LAS float* scr = (LAS float*)(c.lds + wave * 17408);
    const int gw = c.bid * NWAVES + wave, NGW = c.G * NWAVES;
    constexpr int I_IN = (DM / 64) * (INW / 64), I_GLU = (SW / 64) * (SW / 64), I_OUT = (DM / 64) * (DM / 64);
    const int NIT = I_IN + I_GLU + I_OUT + (l == 0 ? NITE : 0);
    for (int it = gw; it < NIT; it += NGW) { int r = it;
        if (r < I_IN) { const int kb = r / (INW / 64), nb = r % (INW / 64), n0 = nb * 64;
            const int dr = n0 < CW ? 256 * (n0 >> 7) + (n0 & 127) : (n0 < 2 * CW ? 256 * ((n0 - CW) >> 7) + 128 + ((n0 - CW) & 127) : n0);
            transpose_item_q8(c.in[2] + (size_t)l * DM * INW, INW, (unsigned char*)WinT, DM, c.in[1] + l * DM, WSP(const float, WS_WMAX) + l * INW, scr, kb * 64, n0, dr, lane); continue; } r -= I_IN;
        if (r < I_GLU) { const int kb = r / (SW / 64), nb = r % (SW / 64); transpose_item(c.in[15] + (size_t)l * SW * SW, SW, GluT, SW, nullptr, scr, kb * 64, nb * 64, nb * 64, lane); continue; } r -= I_GLU;
        if (r < I_OUT) { const int kb = r / (DM / 64), nb = r % (DM / 64); transpose_item_q8(c.in[18] + (size_t)l * DM * DM, DM, (unsigned char*)WoutT, DM, c.in[17] + l * DM, WSP(const float, WS_WMAXO) + l * DM, scr, kb * 64, nb * 64, nb * 64, lane, true); continue; } r -= I_OUT;
        expert_item(c, 0, r, scr, lane);
    }
}
__device__ __forceinline__ void bg_finish(const Ctx& c, int lw, int& done) {
    if (lw < 1 || lw >= DEPTH) return;
    OPQ(); LAS float* scr = (LAS float*)(c.lds + wave * 17408); const int gw = c.bid * NWAVES + wave, NGW = c.G * NWAVES;
    for (; gw + done * NGW < NITE; ++done) expert_item(c, lw, gw + done * NGW, scr, lane);
}
__device__ __forceinline__ void ph_gemm_in(const Ctx& c) {
    eng::DenseOrder S; S.init(NTOK, INW, c.G, c.bid, DM, DM);
    eng::gemm_phase(c.lds, eng::Geo{DM, 128, 128, DM / 128}, WSP(h16, WS_X8), WSP(h16, WS_WIN), S, EpiIn{WSP(h16, WS_U), WSP(h16, WS_SG), WSP(const float, WS_RR0), WSP(const float, WS_WMAX) + c.l * INW}, c.wv);
}
__device__ __forceinline__ void ph_ssm_s(const Ctx& c) {
    SsmSOrder S; S.G = c.G; S.c = c.bid;
    eng::gemm_phase(c.lds, eng::Geo{1024, 128, 128, 8}, WSP(h16, WS_SG), WSP(h16, WS_BS), S, EpiS{WSP(h16, WS_SG), WSP(const float, WS_AT)}, c.wv);
    if (SsmSOrder::unit_of(c.G, c.bid) >= 0) {
        if (c.wv == 0) { __builtin_amdgcn_fence(__ATOMIC_ACQUIRE, "agent"); asm volatile("s_waitcnt vmcnt(0)" ::: "memory"); }
        __syncthreads();
        SsmYLocal Y; Y.G = c.G; Y.c = c.bid;
        eng::gemm_phase(c.lds, eng::Geo{1280, 128, 128, 10}, WSP(h16, WS_SG), WSP(h16, WS_MY), Y, EpiY{WSP(const h16, WS_SG), c.in[14] + c.l * SW, WSP(h16, WS_VH)}, c.wv);
    }
}
__device__ __forceinline__ void ph_ssm_y(const Ctx& c) {
    SsmYOrder S; S.G = c.G; S.c = c.bid;
    eng::gemm_phase(c.lds, eng::Geo{1280, 128, 128, 10}, WSP(h16, WS_SG), WSP(h16, WS_MY), S, EpiY{WSP(const h16, WS_SG), c.in[14] + c.l * SW, WSP(h16, WS_VH)}, c.wv);
}
__device__ __forceinline__ void ph_gemm_glu(const Ctx& c) {
    GluOrder S; S.init(NTOK, SW, c.G, c.bid, 32, SW * 2);
    eng::gemm_phase(c.lds, eng::Geo{SW * 2, 4u * NTOK * 32u, 128, SW / 64}, WSP(h16, WS_VH), WSP(h16, WS_GLU), S, EpiGlu{WSP(const h16, WS_VH), c.in[16] + c.l * SW, WSP(unsigned char, WS_YH), WSP(float, WS_SSQ2), WSP(float, WS_SIGS), c.lds}, c.wv);
}
__device__ __forceinline__ void ph_conv(const Ctx& c) {
    OPQ(); const int l = c.l;
    const h16* U = WSP(const h16, WS_U); unsigned char* YH8 = WSP(unsigned char, WS_YH); float* SIGC = WSP(float, WS_SIGC);
    LAS h16* Ut = (LAS h16*)c.lds; LAS h16* Ot = (LAS h16*)(c.lds + 94 * 1024);
    const int cp = tid & 255, th = tid >> 8;
    const float* cw = c.in[3] + (size_t)l * CKW * CW + 2 * cp;
    h16x2 wp[CKW];
#pragma unroll
    for (int j = 0; j < CKW; ++j) wp[j] = (h16x2){(h16)cw[j * CW], (h16)cw[j * CW + 1]};
    const h16x2 bp = {(h16)c.in[4][l * CW + 2 * cp], (h16)c.in[4][l * CW + 2 * cp + 1]};
    float lg[8], lb[8];
#pragma unroll
    for (int j = 0; j < 8; ++j) { lg[j] = c.in[5][l * CW + lane * 8 + j]; lb[j] = c.in[6][l * CW + lane * 8 + j]; }
    unsigned* cq = WSP(unsigned, WS_CQ) + l * 64; volatile LAS unsigned* slot = (volatile LAS unsigned*)(c.lds + LDS_BYTES - 128);
    __syncthreads();
    if (tid == 0) { slot[0] = atomicAdd(cq, 1u); slot[1] = atomicAdd(cq, 1u); }
    __syncthreads();
    int unit = (int)slot[0], nunit = (int)slot[1];
    u32x4 sv[12];
#define CONV_LOAD(un) do { const int b_ = (un) >> 5, t0_ = ((un) & 31) * 64; _Pragma("unroll") for (int it = 0; it < 12; ++it) { const int q = tid + it * NTHREADS, r = q >> 6, ch = q & 63, t = t0_ - (CKW - 1) + r; \
        sv[it] = (u32x4){0u, 0u, 0u, 0u}; if (q < 94 * 64 && t >= 0) sv[it] = *(const u32x4*)(U + ((size_t)b_ * SEQ + t) * CW + ch * 8); } } while (0)
    if (unit < NTOK / 64) CONV_LOAD(unit);
    for (;;) {
        if (unit >= NTOK / 64) break;
        const int b = unit >> 5, t0 = (unit & 31) * 64; const size_t tokb = (size_t)b * SEQ;
#pragma unroll
        for (int it = 0; it < 12; ++it) { const int q = tid + it * NTHREADS, r = q >> 6, ch = q & 63; if (q < 94 * 64) *(LAS u32x4*)(Ut + r * 512 + ch * 8) = sv[it]; }
        __syncthreads();
        if (nunit < NTOK / 64) CONV_LOAD(nunit);
        unsigned claim = 0u; if (tid == 0) claim = atomicAdd(cq, 1u);
#pragma unroll 1
        for (int half = 0; half < 2; ++half) {
            { const int i0 = half * 32 + th * 16;
                h16x2 a[16];
#pragma unroll
                for (int k = 0; k < 16; ++k) a[k] = bp;
#pragma unroll
                for (int r = 0; r < 46; ++r) { const h16x2 hv = *(const LAS h16x2*)(Ut + (i0 + r) * 512 + 2 * cp);
#pragma unroll
                    for (int k = 0; k < 16; ++k) { const int j = r - k; if (j >= 0 && j < CKW) a[k] = wp[j] * hv + a[k]; } }
#pragma unroll
                for (int k = 0; k < 16; ++k) *(LAS h16x2*)(Ot + (th * 16 + k) * 512 + 2 * cp) = a[k];
            }
            __syncthreads();
            {
                float v[4][8], s1[4], s2[4];
#pragma unroll
                for (int q = 0; q < 4; ++q) { const int lt = wave * 4 + q; const size_t tok = tokb + t0 + half * 32 + lt;
                    const h16x8 hv = *(const LAS h16x8*)(Ot + lt * 512 + lane * 8); s1[q] = 0.f; s2[q] = 0.f;
#pragma unroll
                    for (int j = 0; j < 8; ++j) { v[q][j] = (float)hv[j]; s1[q] += v[q][j]; s2[q] += v[q][j] * v[q][j]; } }
#pragma unroll
                for (int o = 1; o < 64; o <<= 1) {
#pragma unroll
                    for (int q = 0; q < 4; ++q) { s1[q] = xor_add(s1[q], lane, o); s2[q] = xor_add(s2[q], lane, o); } }
                float s3[4], vm[4];
#pragma unroll
                for (int q = 0; q < 4; ++q) { vm[q] = 0.f; const float mean = s1[q] * (1.0f / CW), var = fmaxf(s2[q] * (1.0f / CW) - mean * mean, 0.f), rstd = 1.0f / sqrtf(var + eps_()); s3[q] = 0.f;
#pragma unroll
                    for (int j = 0; j < 8; ++j) { float y = (v[q][j] - mean) * rstd * lg[j] + lb[j]; y = y * fsigmoid(y); v[q][j] = y; s3[q] += y * y; vm[q] = fmaxf(vm[q], fabsf(y)); } }
#pragma unroll
                for (int o = 1; o < 64; o <<= 1) {
#pragma unroll
                    for (int q = 0; q < 4; ++q) { s3[q] = xor_add(s3[q], lane, o); vm[q] = fmaxf(vm[q], __builtin_bit_cast(float, __builtin_amdgcn_ds_bpermute((lane ^ o) << 2, __builtin_bit_cast(int, vm[q])))); } }
#pragma unroll
                for (int q = 0; q < 4; ++q) { const int lt = wave * 4 + q; const size_t tok = tokb + t0 + half * 32 + lt;
                    const float sc = 1.0f / sqrtf(s3[q] * (1.0f / CW) + eps_()), inv = vm[q] > 1e-30f ? 127.0f / vm[q] : 0.f;
                    u32x2 w; w.x = pk_i8(v[q][0], v[q][1], v[q][2], v[q][3], inv); w.y = pk_i8(v[q][4], v[q][5], v[q][6], v[q][7], inv);
                    *(u32x2*)(YH8 + tok * DM + lane * 8) = w; if (lane == 0) SIGC[tok] = sc * vm[q] * (1.0f / 127.0f); }
            }
            if (half == 1 && tid == 0) slot[0] = claim;
            __syncthreads();
        }
        unit = nunit; nunit = (int)slot[0];
    }
#undef CONV_LOAD
}
__device__ __forceinline__ void ph_gemm_out(const Ctx& c) {
    OPQ(); eng::DenseOrder S; S.init(NTOK, DM, c.G, c.bid, DM, DM);
    { LAS float* fac = (LAS float*)(c.lds + 131584); eng::Unit u; const int ui = tid >> 8, r = tid & 255;
      __syncthreads();
      if (S.next(ui, u)) { const int tok = u.pm * 256 + r; const f32x4 q0 = *(const f32x4*)(WSP(const float, WS_SSQ2) + (size_t)tok * 8), q1 = *(const f32x4*)(WSP(const float, WS_SSQ2) + (size_t)tok * 8 + 4);
          const float r2 = 1.0f / sqrtf(((q0[0] + q0[1]) + (q0[2] + q0[3]) + (q1[0] + q1[1]) + (q1[2] + q1[3])) * (1.0f / SW) + eps_());
          const float s0 = WSP(const float, WS_SIGS)[(size_t)tok * 2], s1 = WSP(const float, WS_SIGS)[(size_t)tok * 2 + 1], sc = WSP(const float, WS_SIGC)[tok];
          const float e0 = s0, e1 = s1 > 0.f ? s1 : e0, rho1 = e1 > 0.f ? fminf(e0 / e1, 256.0f) : 1.0f, p1 = e1 * r2, ec = sc > 0.f ? sc : p1, rho2 = ec > 0.f ? fminf(p1 / ec, 256.0f) : 1.0f;
          *(LAS f32x4*)(fac + (size_t)(ui * 256 + r) * 4) = (f32x4){rho1, rho2, ec * (1.0f / 127.0f), 0.f}; }
      __syncthreads(); }
    eng::gemm_phase(c.lds, eng::Geo{DM, 128, 128, DM / 128, 4, 2, 4}, WSP(h16, WS_YH), WSP(h16, WS_WOUT), S, EpiOut{WSP(const h16, WS_HH), c.probe ? WSP(h16, WS_R1) : WSP(h16, WS_HH), WSP(float, WS_SQA), WSP(const float, WS_WMAXO) + c.l * DM, c.lds}, c.wv);
}
__device__ __forceinline__ void ph_router(const Ctx& c) {
    OPQ(); const int l = c.l;
    const h16* X16 = WSP(const h16, WS_HH); u32x4* recs = c.probe ? WSP(u32x4, WS_R1) : WSP(u32x4, WS_LIST); unsigned* cnt = WSP(unsigned, WS_CNT) + l * 2048 + (c.probe ? 32 : 0);
    const float* SQA = WSP(const float, WS_SQA); const h16x8* WRf = WSP(const h16x8, WS_WR); unsigned char* X8B = WSP(unsigned char, WS_X8B);
    LAS float* invl = (LAS float*)(c.lds + 122880);
    const float* brg = c.in[21] + l * MG; const float* bre = c.in[23] + l * NE;
    LAS float* Ps = (LAS float*)(c.lds + wave * 12288);
    LAS float* Lg = (LAS float*)(c.lds + 98304);
    LAS unsigned* cntl = (LAS unsigned*)(c.lds + 131072);
    const int r = lane & 15, q = lane >> 4;
    h16x8 wf[4][3][2];
#pragma unroll
    for (int u = 0; u < 4; ++u)
#pragma unroll
        for (int nb = 0; nb < 3; ++nb) { wf[u][nb][0] = WRf[(((wave * 4 + u) * 3 + nb) * 2 + 0) * 64 + lane]; wf[u][nb][1] = WRf[(((wave * 4 + u) * 3 + nb) * 2 + 1) * 64 + lane]; }
    for (int tile = c.bid; tile < NTOK / 128; tile += c.G) {
        __syncthreads();
        if (tid < 64) cntl[tid] = 0u;
        const int tok0 = tile * 128;
        float rt = 0.f, amx = 0.f;
        if (tid < 128) { const f32x4* sq = (const f32x4*)(SQA + (size_t)(tok0 + tid) * 32); float ssum = 0.f;
#pragma unroll
            for (int i = 0; i < 8; ++i) { const f32x4 v = sq[i]; ssum += v[0] + v[2]; amx = fmaxf(amx, fmaxf(v[1], v[3])); }
            rt = 1.0f / sqrtf(ssum * (1.0f / DM) + eps_()); invl[tid] = amx > 1e-30f ? 127.0f / amx : 0.f; }
        __syncthreads();
#pragma unroll 1
        for (int hf = 0; hf < 2; ++hf) {
            h16x8 xa[4][4];
#pragma unroll
            for (int t = 0; t < 4; ++t)
#pragma unroll
                for (int u = 0; u < 4; ++u) xa[t][u] = *(const h16x8*)(X16 + (size_t)(tok0 + (hf * 4 + t) * 16 + r) * DM + wave * 128 + q * 32 + u * 8);
#pragma unroll
            for (int t = 0; t < 4; ++t) { const int tl = (hf * 4 + t) * 16 + r; const float inv = invl[tl]; u32x4 w0, w1;
                w0.x = pk_i8((float)xa[t][0][0], (float)xa[t][0][1], (float)xa[t][0][2], (float)xa[t][0][3], inv); w0.y = pk_i8((float)xa[t][0][4], (float)xa[t][0][5], (float)xa[t][0][6], (float)xa[t][0][7], inv);
                w0.z = pk_i8((float)xa[t][1][0], (float)xa[t][1][1], (float)xa[t][1][2], (float)xa[t][1][3], inv); w0.w = pk_i8((float)xa[t][1][4], (float)xa[t][1][5], (float)xa[t][1][6], (float)xa[t][1][7], inv);
                w1.x = pk_i8((float)xa[t][2][0], (float)xa[t][2][1], (float)xa[t][2][2], (float)xa[t][2][3], inv); w1.y = pk_i8((float)xa[t][2][4], (float)xa[t][2][5], (float)xa[t][2][6], (float)xa[t][2][7], inv);
                w1.z = pk_i8((float)xa[t][3][0], (float)xa[t][3][1], (float)xa[t][3][2], (float)xa[t][3][3], inv); w1.w = pk_i8((float)xa[t][3][4], (float)xa[t][3][5], (float)xa[t][3][6], (float)xa[t][3][7], inv);
                u32x4* dp = (u32x4*)(X8B + (size_t)(tok0 + tl) * DM + wave * 128 + q * 32); dp[0] = w0; dp[1] = w1; }
#pragma unroll
            for (int t = 0; t < 4; ++t) { f32x4 acc[3];
#pragma unroll
                for (int nb = 0; nb < 3; ++nb) acc[nb] = (f32x4){0.f, 0.f, 0.f, 0.f};
#pragma unroll
                for (int u = 0; u < 4; ++u)
#pragma unroll
                    for (int nb = 0; nb < 3; ++nb) {
                        acc[nb] = __builtin_amdgcn_mfma_f32_16x16x32_f16(xa[t][u], wf[u][nb][0], acc[nb], 0, 0, 0);
                        acc[nb] = __builtin_amdgcn_mfma_f32_16x16x32_f16(xa[t][u], wf[u][nb][1], acc[nb], 0, 0, 0); }
#pragma unroll
                for (int nb = 0; nb < 3; ++nb)
#pragma unroll
                    for (int rg = 0; rg < 4; ++rg) Ps[(t * 16 + q * 4 + rg) * 48 + nb * 16 + r] = acc[nb][rg]; }
            __syncthreads();
            for (int i = tid; i < 64 * 48; i += NTHREADS) { float s = 0.f;
#pragma unroll
                for (int w = 0; w < NWAVES; ++w) s += ((const LAS float*)(c.lds + w * 12288))[i];
                Lg[hf * 64 * 48 + i] = s; }
            __syncthreads();
        }
        int ea = 0, eb = 0; float g1 = 0.f, g2 = 0.f; unsigned pla = 0u, plb = 0u;
        if (tid < 128) {
            float lg[MG + NE];
#pragma unroll
            for (int o4 = 0; o4 < (MG + NE) / 4; ++o4) { const f32x4 t4 = *(const LAS f32x4*)(Lg + tid * 48 + o4 * 4); lg[o4 * 4] = t4[0] * rt; lg[o4 * 4 + 1] = t4[1] * rt; lg[o4 * 4 + 2] = t4[2] * rt; lg[o4 * 4 + 3] = t4[3] * rt; }
            float gl[MG];
#pragma unroll
            for (int o = 0; o < MG; ++o) gl[o] = lg[o] + brg[o];
            int grp = 0; float gm = gl[0];
#pragma unroll
            for (int o = 1; o < MG; ++o) if (gl[o] > gm) { gm = gl[o]; grp = o; }
            float den = 0.f;
#pragma unroll
            for (int o = 0; o < MG; ++o) den += expf(gl[o] - gm);
            const float pg = 1.0f / den;
            float ev[EPG];
#pragma unroll
            for (int j = 0; j < EPG; ++j) { ev[j] = 0.f;
#pragma unroll
                for (int qq = 0; qq < MG; ++qq) ev[j] = (grp == qq) ? (lg[MG + qq * EPG + j] + bre[qq * EPG + j]) : ev[j]; }
            int i1 = 0; float v1 = ev[0];
#pragma unroll
            for (int j = 1; j < EPG; ++j) if (ev[j] > v1) { v1 = ev[j]; i1 = j; }
            int i2 = -1; float v2 = -3.0e38f;
#pragma unroll
            for (int j = 0; j < EPG; ++j) if (j != i1 && ev[j] > v2) { v2 = ev[j]; i2 = j; }
            const float e2 = expf(v2 - v1); g1 = pg / (1.0f + e2); g2 = pg * e2 / (1.0f + e2);
            ea = grp * EPG + i1; eb = grp * EPG + i2;
            pla = __hip_atomic_fetch_add(cntl + ea, 1u, __ATOMIC_RELAXED, __HIP_MEMORY_SCOPE_WORKGROUP);
            plb = __hip_atomic_fetch_add(cntl + eb, 1u, __ATOMIC_RELAXED, __HIP_MEMORY_SCOPE_WORKGROUP);
        }
        __syncthreads();
        if (tid < NE) cntl[32 + tid] = atomicAdd(&cnt[tid * 64], cntl[tid]);
        __syncthreads();
        if (tid < 128) { const int tok = tok0 + tid; const unsigned rb = __float_as_uint(rt * amx * (1.0f / (127.0f * 127.0f)));
            recs[(size_t)ea * NTOK + cntl[32 + ea] + pla] = (u32x4){(unsigned)(tok * 2), __float_as_uint(g1), rb, 0u};
            recs[(size_t)eb * NTOK + cntl[32 + eb] + plb] = (u32x4){(unsigned)(tok * 2 + 1), __float_as_uint(g2), rb, 0u}; }
    }
}
__device__ __forceinline__ void ph_moe_tb(const Ctx& c) {
    OPQ(); LAS int* tb = (LAS int*)(c.lds + 131072); const unsigned* cnt = WSP(const unsigned, WS_CNT) + c.l * 2048;
    __syncthreads();
    if (tid < NE) tb[40 + tid] = (int)cnt[tid * 64];
    __syncthreads();
    if (tid == 0) { int a = 0; for (int e = 0; e < NE; ++e) { tb[e] = a; a += (tb[40 + e] + 255) / 256; } tb[NE] = a; }
    __syncthreads();
}
__device__ __forceinline__ void ph_moe_gu(const Ctx& c) {
    LAS int* tb = (LAS int*)(c.lds + 131072);
    MoeGU S; S.tb = tb; S.G = c.G; S.c = c.bid; S.T = __builtin_amdgcn_readfirstlane(tb[NE]); S.list = WSP(const unsigned, WS_LIST);
    eng::gemm_phase(c.lds, eng::Geo{DM, 128, 128, DM / 128}, WSP(h16, WS_X8B), WSP(h16, WS_WGU8), S, EpiHid{WSP(h16, WS_R1), WSP(const unsigned, WS_LIST), tb, WSP(unsigned, WS_TC) + (size_t)c.l * 288 * 64, WSP(const float, WS_WME) + (size_t)c.l * NE * 1024}, c.wv);
}
__device__ __forceinline__ void ph_moe_down(const Ctx& c) {
    LAS int* tb = (LAS int*)(c.lds + 131072);
    MoeDown S; S.tb = tb; S.G = c.G; S.c = c.bid; S.T = __builtin_amdgcn_readfirstlane(tb[NE]); S.flip = true; S.tc = WSP(unsigned, WS_TC) + (size_t)c.l * 288 * 64; S.tmo = WSP(unsigned, WS_CTL) + XB_TMO;
    eng::gemm_phase(c.lds, eng::Geo{DE * 2, 128, 128, DE / 64}, WSP(h16, WS_R1), WD_SET(c.l), S, EpiScat{WSP(unsigned char, WS_R3), WSP(float, WS_R3 + 64 * MiB), WSP(const unsigned, WS_LIST), tb}, c.wv);
}
__device__ __forceinline__ void ph_combine(const Ctx& c) {
    OPQ(); const h16* X16 = WSP(const h16, WS_HH); h16* Xo = c.probe ? WSP(h16, WS_R1) : WSP(h16, WS_HH); float* RR0 = c.probe ? WSP(float, WS_R1 + 128 * MiB) : WSP(float, WS_RR0);
    const unsigned* YS8 = WSP(const unsigned, WS_R3); const float* YSC = WSP(const float, WS_R3 + 64 * MiB); const bool lastl = (c.l == DEPTH - 1) && !c.probe; const float* gfin = c.in[27]; unsigned* X8 = WSP(unsigned, WS_X8);
    const int NW = c.G * NWAVES;
    for (int row0 = c.bid * NWAVES + wave; row0 < NTOK; row0 += 2 * NW) {
        h16x4 xv[2][4]; unsigned ya[2][4], yb[2][4]; float sa[2][4], sb[2][4];
#pragma unroll
        for (int t = 0; t < 2; ++t) { const int row = row0 + t * NW < NTOK ? row0 + t * NW : row0;
            const h16x4* xr = (const h16x4*)(X16 + (size_t)row * DM) + lane; const unsigned* pa = YS8 + (size_t)row * 2 * (DM / 4) + (((lane & 31) >> 3) * 16 + ((lane & 7) >> 1) * 4 + (lane >> 5) * 2 + (lane & 1)); const unsigned* pb = pa + DM / 4;
            const float* qa = YSC + (size_t)row * 32 + ((lane & 31) >> 3);
#pragma unroll
            for (int j = 0; j < 4; ++j) { xv[t][j] = xr[64 * j]; ya[t][j] = __builtin_nontemporal_load(pa + 64 * j); yb[t][j] = __builtin_nontemporal_load(pb + 64 * j); sa[t][j] = qa[j * 4]; sb[t][j] = qa[16 + j * 4]; } }
#pragma unroll
        for (int t = 0; t < 2; ++t) { const int row = row0 + t * NW; if (row >= NTOK) break;
            f32x4 v[4]; float s = 0.f;
#pragma unroll
            for (int j = 0; j < 4; ++j) { const h16x4 x = xv[t][j]; const unsigned a = ya[t][j], b = yb[t][j]; const float fa = sa[t][j], fb = sb[t][j], off = -128.0f * (fa + fb);
                const f32x4 ua = {(float)(a & 255u), (float)((a >> 8) & 255u), (float)((a >> 16) & 255u), (float)(a >> 24)}, ub = {(float)(b & 255u), (float)((b >> 8) & 255u), (float)((b >> 16) & 255u), (float)(b >> 24)};
                v[j] = (f32x4){(float)x[0], (float)x[1], (float)x[2], (float)x[3]} + ((ua * fa + ub * fb) + off); }
            if (!lastl) { h16x4* xw = (h16x4*)(Xo + (size_t)row * DM) + lane; float am = 0.f;
#pragma unroll
                for (int j = 0; j < 4; ++j) { h16x4 h;
#pragma unroll
                    for (int e = 0; e < 4; ++e) { h[e] = (h16)v[j][e]; const float f = (float)h[e]; v[j][e] = f; s += f * f; am = fmaxf(am, fabsf(f)); }
                    xw[64 * j] = h; }
                const float r = 1.0f / sqrtf(wave_sum(s, lane) * (1.0f / DM) + eps_());
                am = wave_max(am, lane); const float inv = am > 1e-30f ? 127.0f / am : 0.f;
#pragma unroll
                for (int j = 0; j < 4; ++j) X8[(size_t)row * (DM / 4) + lane + 64 * j] = pk_i8(v[j][0], v[j][1], v[j][2], v[j][3], inv);
                if (lane == 0) RR0[row] = r * am * (1.0f / (127.0f * 127.0f)); }
            else {
#pragma unroll
                for (int j = 0; j < 4; ++j) s += v[j][0] * v[j][0] + v[j][1] * v[j][1] + v[j][2] * v[j][2] + v[j][3] * v[j][3];
                const float r = 1.0f / sqrtf(wave_sum(s, lane) * (1.0f / DM) + eps_());
                f32x4* orow = (f32x4*)(c.out + (size_t)row * DM) + lane;
#pragma unroll
                for (int j = 0; j < 4; ++j) { const f32x4 gv = ((const f32x4*)gfin)[lane + 64 * j]; __builtin_nontemporal_store(v[j] * r * gv, orow + 64 * j); } }
        }
    }
}
#undef WSP
#undef OPQ

__device__ __forceinline__ void xcd_barrier_bg(const XcdBarrier& b, volatile LAS unsigned* relw, unsigned gen, const Ctx& c, int lw, int& done) {
    asm volatile("s_waitcnt vmcnt(0)" ::: "memory");
    __syncthreads();
    int tid = c.wv * 64 + lane_id_(); asm volatile("" : "+v"(tid)); const int lane = tid & 63, wave = __builtin_amdgcn_readfirstlane(tid >> 6);
    if (wave == 0) {
        if (tid == 0) {
            unsigned* bar = b.bar;
            __builtin_amdgcn_s_waitcnt(0);
            unsigned nloc = b.st[0], nx = b.st[1];
            if (nloc == 0u) { xcd_barrier_complete(bar, b.x, nloc, nx); b.st[0] = nloc; b.st[1] = nx; }
            const unsigned old = xb_add(&bar[XB_XSUB(b.x)], 1u);
            const unsigned g2 = old / nloc;
            if (old + 1u == (g2 + 1u) * nloc) {
                __builtin_amdgcn_fence(__ATOMIC_RELEASE, "agent");
                asm volatile("s_waitcnt vmcnt(0)" ::: "memory");
                const unsigned og = xb_add(&bar[XB_TOP], 1u);
                const unsigned tg = og / nx;
                if (og + 1u == (tg + 1u) * nx) xb_add(&bar[XB_TOPGEN], 1u);
                else XB_SPIN(xb_ld(&bar[XB_TOPGEN]) == tg, bar);
                __builtin_amdgcn_fence(__ATOMIC_ACQUIRE, "agent");
                xb_add(&bar[XB_XGEN(b.x)], 1u);
                asm volatile("s_waitcnt vmcnt(0)" ::: "memory");
            } else {
                XB_SPIN(xb_ld(&bar[XB_XGEN(b.x)]) == g2, bar);
                __builtin_amdgcn_fence(__ATOMIC_ACQUIRE, "agent");
                asm volatile("s_waitcnt vmcnt(0)" ::: "memory");
            }
            *relw = gen;
        }
    } else if (lw >= 1 && lw < DEPTH) {
        LAS float* scr = (LAS float*)(c.lds + wave * 17408); const int gw = c.bid * NWAVES + wave, NGW = c.G * NWAVES;
        while (*relw != gen && gw + done * NGW < NITE) { expert_item(c, lw, gw + done * NGW, scr, lane); ++done; }
    }
    __syncthreads();
}

__global__ void __launch_bounds__(NTHREADS, 2) fwd(Args args) {
    extern __shared__ __attribute__((aligned(16))) unsigned char lds_raw[];
    LAS unsigned char* lds = (LAS unsigned char*)lds_raw;
    const int tid0 = threadIdx.x; const int swv = __builtin_amdgcn_readfirstlane(tid0 >> 6);
    volatile LAS unsigned* MISC = (volatile LAS unsigned*)(lds + LDS_BYTES - 64);
    if (tid0 < 16) MISC[tid0] = 0u;
    __syncthreads();
    XcdBarrier bar; bar.bar = (unsigned*)(args.ws + WS_CTL); bar.x = 0; bar.st = nullptr;
    if (MK_ONE_LAUNCH) bar = xcd_barrier_post((unsigned*)(args.ws + WS_CTL), MISC);
    const int lo = args.ph_lo, hi = args.ph_hi;
#define IN(k) (lo <= (k) && (k) < hi)
    unsigned bgen = 0u; int bg_done = 0;
#define SEAM(k) do { if (IN(k) && IN((k) + 1)) { int l_ = l + 1; GAS unsigned char* w_ = (GAS unsigned char*)args.ws; asm volatile("" : "+s"(l_), "+s"(w_)); Ctx c_{args.in, args.out, w_, lds, l_, (int)gridDim.x, (int)blockIdx.x, 0, swv}; \
        ++bgen; xcd_barrier_bg(bar, MISC + 4, bgen, c_, l_, bg_done); } } while (0)
#define RUN(k, fn) do { for (int rep_ = 0; rep_ < ((((DUP_MASK) >> ((k) % PPL)) & 1) && (k) < DEPTH * PPL ? 2 : 1); ++rep_) if (IN(k)) { int l_ = l; GAS unsigned char* w_ = (GAS unsigned char*)args.ws; asm volatile("" : "+s"(l_), "+s"(w_)); Ctx c_{args.in, args.out, w_, lds, l_, (int)gridDim.x, (int)blockIdx.x, rep_, swv}; fn(c_); } } while (0)
    for (int l = 0; l < DEPTH; ++l) {
        const int pb = l * PPL;
        if (l == 0) { RUN(pb + 0, ph_wmax); RUN(pb + 0, ph_norm_in); RUN(pb + 0, ph_tables);
            if (IN(pb + 0)) { int l_ = l + 1; GAS unsigned char* w_ = (GAS unsigned char*)args.ws; asm volatile("" : "+s"(l_), "+s"(w_)); Ctx c_{args.in, args.out, w_, lds, l_, (int)gridDim.x, (int)blockIdx.x, 0, swv};
                ++bgen; xcd_barrier_bg(bar, MISC + 4, bgen, c_, l_, bg_done); }
            RUN(pb + 0, ph_weights); RUN(pb + 0, ph_wstrips); SEAM(pb + 0); }
        RUN(pb + 1, ph_gemm_in); SEAM(pb + 1);
        RUN(pb + 2, ph_ssm_s); RUN(pb + 2, ph_conv); SEAM(pb + 2);
        RUN(pb + 5, ph_gemm_glu); SEAM(pb + 5);
        RUN(pb + 7, ph_gemm_out); SEAM(pb + 7);
        RUN(pb + 8, ph_router); SEAM(pb + 8);
#define MOE_TB() do { int l_ = l; GAS unsigned char* w_ = (GAS unsigned char*)args.ws; asm volatile("" : "+s"(l_), "+s"(w_)); Ctx c_{args.in, args.out, w_, lds, l_, (int)gridDim.x, (int)blockIdx.x, 0, swv}; ph_moe_tb(c_); } while (0)
        if (IN(pb + 9)) MOE_TB();
        RUN(pb + 9, ph_moe_gu);
        RUN(pb + 9, ph_moe_down); SEAM(pb + 10);
        RUN(pb + 11, ph_combine);
        if (l + 1 < DEPTH) { const int lcur = l; { const int l = lcur + 1; RUN(pb + 11, ph_tables); RUN(pb + 11, ph_weights); RUN(pb + 11, ph_wstrips); }
            if (IN(pb + 11)) { int l_ = l + 1; GAS unsigned char* w_ = (GAS unsigned char*)args.ws; asm volatile("" : "+s"(l_), "+s"(w_)); Ctx c_{args.in, args.out, w_, lds, l_, (int)gridDim.x, (int)blockIdx.x, 0, swv}; __syncthreads(); bg_finish(c_, l_, bg_done); } }
        bg_done = NITE;
        SEAM(pb + 11);
        bg_done = 0;
    }
#undef IN
#undef SEAM
#undef RUN
#undef MOE_TB
}
}

extern "C" void kernel_launch(void* const* d_in, const int* in_sizes, int n_in, void* d_out, int out_size, void* d_ws, size_t ws_size, hipStream_t stream) {
    static int grid = 0;
    if (grid == 0) {
        if (n_in != 28 || out_size != NTOK * DM || ws_size < WS_END) { fprintf(stderr, "kernel_launch: unexpected shapes (n_in %d out %d ws %zu need %zu)\n", n_in, out_size, ws_size, (size_t)WS_END); grid = -1; return; }
        int dev = 0, cus = 0;
        if (hipGetDevice(&dev) != hipSuccess || hipDeviceGetAttribute(&cus, hipDeviceAttributeMultiprocessorCount, dev) != hipSuccess) { grid = -1; return; }
        if (hipFuncSetAttribute((const void*)fwd, hipFuncAttributeMaxDynamicSharedMemorySize, LDS_BYTES) != hipSuccess) { fprintf(stderr, "kernel_launch: hipFuncSetAttribute failed\n"); grid = -1; return; }
        int per_cu = 0;
        if (hipOccupancyMaxActiveBlocksPerMultiprocessor(&per_cu, (const void*)fwd, NTHREADS, LDS_BYTES) != hipSuccess || per_cu < 1) { fprintf(stderr, "kernel_launch: occupancy query says %d\n", per_cu); }
        (void)hipGetLastError();
        if (cus < 256) { fprintf(stderr, "kernel_launch: needs >= 256 CUs (has %d): the output projection keeps the row factors of at most two units per workgroup in LDS\n", cus); grid = -1; return; }
        grid = cus;
    }
    if (grid < 0) return;
    (void)hipMemsetAsync((char*)d_ws + WS_CTL, 0, ZERO_BYTES, stream);
    Args a{};
    for (int i = 0; i < 28; ++i) a.in[i] = (const float*)d_in[i];
    a.out = (float*)d_out; a.ws = (unsigned char*)d_ws;
#if MK_ONE_LAUNCH
    a.ph_lo = 0; a.ph_hi = NPH;
    hipLaunchKernelGGL(fwd, dim3(grid), dim3(NTHREADS), LDS_BYTES, stream, a);
#else
    for (int p = 0; p < NPH; ++p) { a.ph_lo = p; a.ph_hi = p + 1; hipLaunchKernelGGL(fwd, dim3(grid), dim3(NTHREADS), LDS_BYTES, stream, a); }
#endif
}
```

```cpp
#include <hip/hip_runtime.h>
#include <cstdio>
#include <cstdint>

#ifndef DUP_MASK
#define DUP_MASK 0
#endif
#ifndef MK_ONE_LAUNCH
#define MK_ONE_LAUNCH 1
#endif

namespace {
#define LAS __attribute__((address_space(3)))
#define GAS __attribute__((address_space(1)))
typedef float f32x4 __attribute__((ext_vector_type(4)));
typedef int i32x4 __attribute__((ext_vector_type(4)));

constexpr int DM = 1024, BATCH = 16, SEQ = 2048, DEPTH = 4, NTOK = BATCH * SEQ;
constexpr int CW = 512, SW = 512, CKW = 31, SGC = 16, NG = 32, NS = 64, INW = 1536;
constexpr int MG = 4, EPG = 8, NE = 32, DE = 512;
constexpr float EPS = 1e-6f;
__device__ __forceinline__ float eps_() { float e = EPS; asm volatile("" : "+v"(e)); return e; }
constexpr int NTHREADS = 512, NWAVES = 8;
constexpr int LDS_BYTES = 147456;

constexpr size_t MiB = 1u << 20;
constexpr size_t WS_CTL = 0;
constexpr size_t CTL_BYTES = 64 * 1024;
constexpr size_t WS_CNT = CTL_BYTES;
constexpr size_t WS_CQ = CTL_BYTES + 32768;
constexpr size_t WS_TC = 128 * 1024;
constexpr size_t WS_WMAX = WS_TC + DEPTH * 288 * 256;
constexpr size_t WS_WME = WS_WMAX + DEPTH * 1536 * 4;
constexpr size_t WS_WMAXO = WS_WME + (size_t)DEPTH * 32 * 1024 * 4;
constexpr size_t ZERO_BYTES = WS_WMAXO + DEPTH * 1024 * 4;
constexpr size_t WS_R1 = 8 * MiB;
constexpr size_t WS_X8 = WS_R1 + 96 * MiB;
constexpr size_t WS_X8B = WS_R1 + 128 * MiB;
constexpr size_t WS_WGU8 = WS_R1 + 160 * MiB;
constexpr size_t WS_R3 = WS_R1 + 192 * MiB;
constexpr size_t WS_SQA = WS_R3 + 72 * MiB;
constexpr size_t WS_HH = WS_R3 + 128 * MiB;
constexpr size_t WS_YH = WS_HH + 64 * MiB;
constexpr size_t WS_SIGS = WS_YH + 32 * MiB;
constexpr size_t WS_SIGC = WS_YH + 33 * MiB;
constexpr size_t WS_VH = WS_YH + 64 * MiB;
constexpr size_t WS_WIN = WS_VH + 32 * MiB;
constexpr size_t WS_GLU = WS_WIN + 3 * MiB;
constexpr size_t WS_WOUT = WS_GLU + 1 * MiB;
constexpr size_t WS_WGU = WS_WOUT + 2 * MiB;
constexpr size_t WS_WD = WS_WGU + 64 * MiB;
constexpr size_t WS_U = WS_WD + 32 * MiB;
constexpr size_t WS_SG = WS_U + 32 * MiB;
constexpr size_t WS_BS = WS_SG + 40 * MiB;
constexpr size_t WS_MY = WS_BS + 8 * MiB;
constexpr size_t WS_AT = WS_MY + 20 * MiB;
constexpr size_t WS_SSQ2 = WS_AT + 1 * MiB;
constexpr size_t WS_SSQ1 = WS_SSQ2 + 1 * MiB;
constexpr size_t WS_WR = WS_SSQ1 + 2 * MiB;
constexpr size_t WS_RR0 = WS_WR + 1 * MiB;
constexpr size_t WS_RR1 = WS_RR0 + 1 * MiB;
constexpr size_t WS_LIST = WS_RR1 + 1 * MiB;
constexpr size_t WS_W2 = WS_LIST + 16 * MiB;
constexpr size_t WS_END = WS_W2 + 96 * MiB;

#define XB_TMO      128
#define XB_XCNT(j)  (256  + 64 * (j))
#define XB_XSUB(j)  (1280 + 64 * (j))
#define XB_XGEN(j)  (2304 + 64 * (j))
#define XB_TOP      3328
#define XB_TOPGEN   3392
#define XCD_BAR_WORDS 3456
#define XB_SPIN_CAP (1u << 22)

__device__ __forceinline__ unsigned xb_ld(unsigned* p)              { return __hip_atomic_load(p, __ATOMIC_RELAXED, __HIP_MEMORY_SCOPE_AGENT); }
__device__ __forceinline__ unsigned xb_add(unsigned* p, unsigned v) { return __hip_atomic_fetch_add(p, v, __ATOMIC_RELAXED, __HIP_MEMORY_SCOPE_AGENT); }
__device__ __forceinline__ unsigned xb_xcc_id() { return (unsigned)__builtin_amdgcn_s_getreg((3 << 11) | 20) & 0xFu; }
#define XB_SPIN(cond, bar) do { unsigned _sp = 0; while (cond) { __builtin_amdgcn_s_sleep(1); \
    if ((++_sp & 255u) == 0u) { if (xb_ld(&(bar)[XB_TMO])) break; if (_sp > XB_SPIN_CAP) { atomicAdd(&(bar)[XB_TMO], 1u); break; } } } } while (0)

struct XcdBarrier { unsigned* bar; unsigned x; volatile LAS unsigned* st; };

__device__ __forceinline__ XcdBarrier xcd_barrier_post(unsigned* bar, volatile LAS unsigned* st) {
    XcdBarrier b; b.bar = bar; b.x = xb_xcc_id(); b.st = st;
    if (threadIdx.x == 0) (void)xb_add(&bar[XB_XCNT(b.x)], 1u);
    return b;
}
__device__ __forceinline__ void xcd_barrier_complete(unsigned* bar, unsigned x, unsigned& nloc, unsigned& nx) {
    const unsigned G = gridDim.x * gridDim.y * gridDim.z;
    unsigned sum, cnt, mine, sp = 0u;
    for (;;) {
        sum = 0u; cnt = 0u; mine = 0u;
#pragma unroll
        for (unsigned j = 0; j < 16; ++j) { const unsigned c = xb_ld(&bar[XB_XCNT(j)]); sum += c; cnt += (c > 0u) ? 1u : 0u; mine = (j == x) ? c : mine; }
        if (sum == G) break;
        __builtin_amdgcn_s_sleep(1);
        if ((++sp & 255u) == 0u) { if (xb_ld(&bar[XB_TMO])) break; if (sp > XB_SPIN_CAP) { atomicAdd(&bar[XB_TMO], 1u); break; } }
    }
    nloc = mine > 0u ? mine : 1u; nx = cnt > 0u ? cnt : 1u;
}
__device__ __forceinline__ void xcd_barrier(const XcdBarrier& b) {
    asm volatile("s_waitcnt vmcnt(0)" ::: "memory");
    __syncthreads();
    if (threadIdx.x == 0) {
        unsigned* bar = b.bar;
        __builtin_amdgcn_s_waitcnt(0);
        unsigned nloc = b.st[0], nx = b.st[1];
        if (nloc == 0u) { xcd_barrier_complete(bar, b.x, nloc, nx); b.st[0] = nloc; b.st[1] = nx; }
        const unsigned old = xb_add(&bar[XB_XSUB(b.x)], 1u);
        const unsigned gen = old / nloc;
        if (old + 1u == (gen + 1u) * nloc) {
            __builtin_amdgcn_fence(__ATOMIC_RELEASE, "agent");
            asm volatile("s_waitcnt vmcnt(0)" ::: "memory");
            const unsigned og = xb_add(&bar[XB_TOP], 1u);
            const unsigned tg = og / nx;
            if (og + 1u == (tg + 1u) * nx) xb_add(&bar[XB_TOPGEN], 1u);
            else XB_SPIN(xb_ld(&bar[XB_TOPGEN]) == tg, bar);
            __builtin_amdgcn_fence(__ATOMIC_ACQUIRE, "agent");
            xb_add(&bar[XB_XGEN(b.x)], 1u);
            asm volatile("s_waitcnt vmcnt(0)" ::: "memory");
        } else {
            XB_SPIN(xb_ld(&bar[XB_XGEN(b.x)]) == gen, bar);
            __builtin_amdgcn_fence(__ATOMIC_ACQUIRE, "agent");
            asm volatile("s_waitcnt vmcnt(0)" ::: "memory");
        }
    }
    __syncthreads();
}

__device__ __forceinline__ int lane_id_() { int ln; asm volatile("v_mbcnt_lo_u32_b32 %0, -1, 0\n\tv_mbcnt_hi_u32_b32 %0, -1, %0" : "=v"(ln)); return ln; }
__device__ __forceinline__ float wave_sum(float v, int lane) {
#pragma unroll
    for (int o = 1; o < 64; o <<= 1) v += __builtin_bit_cast(float, __builtin_amdgcn_ds_bpermute((lane ^ o) << 2, __builtin_bit_cast(int, v)));
    return v;
}

__device__ __forceinline__ float wave_max(float v, int lane) {
#pragma unroll
    for (int o = 1; o < 64; o <<= 1) v = fmaxf(v, __builtin_bit_cast(float, __builtin_amdgcn_ds_bpermute((lane ^ o) << 2, __builtin_bit_cast(int, v))));
    return v;
}
__device__ __forceinline__ unsigned pk_i8(float a, float b, float c, float d, float inv) {
    unsigned w = __builtin_amdgcn_cvt_pk_u8_f32(__builtin_rintf(__builtin_fmaf(a, inv, 128.0f)), 0u, 0u);
    w = __builtin_amdgcn_cvt_pk_u8_f32(__builtin_rintf(__builtin_fmaf(b, inv, 128.0f)), 1u, w); w = __builtin_amdgcn_cvt_pk_u8_f32(__builtin_rintf(__builtin_fmaf(c, inv, 128.0f)), 2u, w);
    w = __builtin_amdgcn_cvt_pk_u8_f32(__builtin_rintf(__builtin_fmaf(d, inv, 128.0f)), 3u, w);
    return w ^ 0x80808080u;
}
__device__ __forceinline__ unsigned pk_u8o(float a, float b, float c, float d, float inv) {
    unsigned w = __builtin_amdgcn_cvt_pk_u8_f32(__builtin_rintf(__builtin_fmaf(a, inv, 128.0f)), 0u, 0u);
    w = __builtin_amdgcn_cvt_pk_u8_f32(__builtin_rintf(__builtin_fmaf(b, inv, 128.0f)), 1u, w); w = __builtin_amdgcn_cvt_pk_u8_f32(__builtin_rintf(__builtin_fmaf(c, inv, 128.0f)), 2u, w);
    return __builtin_amdgcn_cvt_pk_u8_f32(__builtin_rintf(__builtin_fmaf(d, inv, 128.0f)), 3u, w);
}
typedef _Float16 h16;
typedef _Float16 h16x8 __attribute__((ext_vector_type(8)));
typedef _Float16 h16x2 __attribute__((ext_vector_type(2)));
typedef _Float16 h16x4 __attribute__((ext_vector_type(4)));
typedef unsigned u32x4 __attribute__((ext_vector_type(4)));
typedef unsigned u32x2 __attribute__((ext_vector_type(2)));
__device__ __forceinline__ unsigned pk_h16(float a, float b) { h16x2 v = {(h16)a, (h16)b}; return __builtin_bit_cast(unsigned, v); }
namespace eng {
constexpr int BM = 256, BK = 64, HALF = 128, HTB = HALF * BK * 2, STAGE_BYTES = 8 * HTB, NXCD = 8, WGM = 8;
__host__ __device__ __forceinline__ int lds_byte(int r, int c) { const int st = (r >> 4) * 2 + (c >> 5), rr = r & 15, cc = c & 31, ob = rr * 64 + cc * 2; return st * 1024 + (ob ^ (((ob >> 9) & 1) << 5)); }
__host__ __device__ __forceinline__ void stage_rc(int b, int& R, int& C) { const int st = b / 1024, sb = b % 1024, swz = sb ^ (((sb >> 9) & 1) << 5); R = (st >> 1) * 16 + swz / 64; C = (st & 1) * 32 + (swz % 64) / 2; }
__host__ __device__ __forceinline__ int perm32(int rho) { const int n = rho >> 4, i = rho & 15; return 8 * (i >> 2) + 4 * n + (i & 3); }
struct Unit { unsigned ao, bo; int pm, pn, e, aux; int nt = 0, kcut = 1 << 20, kskip = 0; };
struct Geo { unsigned ldb, kstepA, kstepB; int nt; int krot = 0, mid = -1, mid2 = -1; };
template <class Epi, class Sched>
__device__ __forceinline__ void gemm_phase(LAS unsigned char* lds, const Geo g, const void* Abase, const void* Bbase, const Sched& S, const Epi& E, int wv) {
    const __amdgpu_buffer_rsrc_t rA = __builtin_amdgcn_make_buffer_rsrc((void*)Abase, 0, 0xFFFFFFF0u, 0x00020000), rB = __builtin_amdgcn_make_buffer_rsrc((void*)Bbase, 0, 0xFFFFFFF0u, 0x00020000);
    int tid = wv * 64 + lane_id_(); asm volatile("" : "+v"(tid));
    const int wid = __builtin_amdgcn_readfirstlane(tid >> 6), lane = tid & 63, wr = wid >> 2, wc = wid & 3, fr = lane & 15, fq = lane >> 4;
    const int nt = g.nt;
    unsigned voffB[2];
#pragma unroll
    for (int i = 0; i < 2; ++i) { int R, C; stage_rc(tid * 16 + i * 8192, R, C); const int Rb = Epi::PERM ? ((R & ~31) + perm32(R & 31)) : R; voffB[i] = (unsigned)Rb * g.ldb + (unsigned)C * 2u; }
    const unsigned hstepB = (unsigned)HALF * g.ldb;
    const unsigned kA = g.kstepA, kB = g.kstepB;
    const unsigned ldsw = (unsigned)wid * 1024u;
    const int aoff = lds_byte(wr * 64 + fr, fq * 8), boff = lds_byte(wc * 32 + fr, fq * 8);
#define EG_SA(b, h) (((b) * 2 + (h)) * HTB)
#define EG_SB(b, h) ((4 + (b) * 2 + (h)) * HTB)
#define EG_STAGE(bufoff, so, v0, v1) do { \
        __builtin_amdgcn_raw_ptr_buffer_load_lds(rA, (LAS void*)(lds + (bufoff) + ldsw), 16, (v0), (so), 0, 0); \
        __builtin_amdgcn_raw_ptr_buffer_load_lds(rA, (LAS void*)(lds + (bufoff) + ldsw + 8192), 16, (v1), (so), 0, 0); } while (0)
#define EG_STB(bufoff, so) do { \
        __builtin_amdgcn_raw_ptr_buffer_load_lds(rB, (LAS void*)(lds + (bufoff) + ldsw), 16, voffB[0], (so), 0, 0); \
        __builtin_amdgcn_raw_ptr_buffer_load_lds(rB, (LAS void*)(lds + (bufoff) + ldsw + 8192), 16, voffB[1], (so), 0, 0); } while (0)
#define EG_LDA(dst, b, h) do { _Pragma("unroll") for (int m = 0; m < 4; ++m) _Pragma("unroll") for (int k = 0; k < 2; ++k) dst[m][k] = *(const LAS h16x8*)(lds + EG_SA(b, h) + aoff + m * 2048 + k * 1024); } while (0)
#define EG_LDB(dst, b, h) do { _Pragma("unroll") for (int n = 0; n < 2; ++n) _Pragma("unroll") for (int k = 0; k < 2; ++k) dst[n][k] = *(const LAS h16x8*)(lds + EG_SB(b, h) + boff + n * 2048 + k * 1024); } while (0)
#define EG_MMA(ai, bj, At, Bt) do { __builtin_amdgcn_s_setprio(1); _Pragma("unroll") for (int m = 0; m < 4; ++m) _Pragma("unroll") for (int n = 0; n < 2; ++n) _Pragma("unroll") for (int k = 0; k < 2; ++k) { \
        if constexpr (Epi::I8) acc[ai][bj][m][n] = __builtin_bit_cast(f32x4, __builtin_amdgcn_mfma_i32_16x16x64_i8(__builtin_bit_cast(i32x4, Bt[n][k]), __builtin_bit_cast(i32x4, At[m][k]), __builtin_bit_cast(i32x4, acc[ai][bj][m][n]), 0, 0, 0)); \
        else acc[ai][bj][m][n] = __builtin_amdgcn_mfma_f32_16x16x32_f16(Bt[n][k], At[m][k], acc[ai][bj][m][n], 0, 0, 0); } __builtin_amdgcn_s_setprio(0); } while (0)
#define EG_WAIT_V(n) asm volatile("s_waitcnt vmcnt(" #n ")" ::: "memory")
#define EG_WAIT_L(n) asm volatile("s_waitcnt lgkmcnt(" #n ")" ::: "memory")
#define EG_BAR __builtin_amdgcn_s_barrier()
#define EG_SCHED __builtin_amdgcn_sched_barrier(0)
    Unit cur, nxt; int ui = 0, pub = -1;
    if (!S.next(0, cur)) return;
    f32x4 acc[2][2][4][2];
#pragma unroll
    for (int a = 0; a < 2; ++a)
#pragma unroll
        for (int b = 0; b < 2; ++b)
#pragma unroll
            for (int m = 0; m < 4; ++m)
#pragma unroll
                for (int n = 0; n < 2; ++n) acc[a][b][m][n] = (f32x4){0.f, 0.f, 0.f, 0.f};
    h16x8 At[4][2], B0[2][2], B1[2][2];
    unsigned cA = cur.ao, cB = cur.bo;
    unsigned cv[2][2], nv[2][2];
    S.a_ready(cur, tid);
    S.a_off(cur, tid, cv);
    if constexpr (Sched::GATHER) {
#pragma unroll
        for (int h = 0; h < 2; ++h)
#pragma unroll
            for (int i = 0; i < 2; ++i) nv[h][i] = cv[h][i];
    }
#define EG_SV(h, i) (Sched::GATHER ? (last ? nv[h][i] : cv[h][i]) : cv[h][i])
    const int krot = g.krot;
#define EG_KT(k) (Sched::KSKIP ? (unsigned)((k) + ((k) >= cur.kcut ? cur.kskip : 0)) : (unsigned)(((k) + krot) >= nt ? (k) + krot - nt : (k) + krot))
    EG_STB(EG_SB(0, 0), cB + EG_KT(0) * kB); EG_STB(EG_SB(0, 1), cB + hstepB + EG_KT(0) * kB); EG_STAGE(EG_SA(0, 0), cA + EG_KT(0) * kA, cv[0][0], cv[0][1]); EG_STAGE(EG_SA(0, 1), cA + EG_KT(0) * kA, cv[1][0], cv[1][1]);
    EG_STB(EG_SB(1, 0), cB + EG_KT(1) * kB); EG_STAGE(EG_SA(1, 0), cA + EG_KT(1) * kA, cv[0][0], cv[0][1]); EG_STB(EG_SB(1, 1), cB + hstepB + EG_KT(1) * kB);
    if (wr == 1) EG_BAR;
    EG_WAIT_V(8); EG_BAR;
    EG_WAIT_V(6); EG_BAR;
    for (;;) {
        const bool has_next = S.next(ui + 1, nxt);
        const unsigned nA = has_next ? nxt.ao : cA, nB = has_next ? nxt.bo : cB;
        if constexpr (Sched::GATHER) { if (has_next) S.a_off(nxt, tid, nv); }
        const int cnt = Sched::KSKIP ? cur.nt : nt;
        for (int t = 0; t < cnt; t += 2) {
            const bool last = (t == cnt - 2);
            const unsigned a1 = cA + EG_KT(t + 1) * kA;
            const unsigned a2 = last ? nA + EG_KT(0) * kA : cA + EG_KT(t + 2) * kA, b2 = last ? nB + EG_KT(0) * kB : cB + EG_KT(t + 2) * kB;
            const unsigned a3 = last ? nA + EG_KT(1) * kA : cA + EG_KT(t + 3) * kA, b3 = last ? nB + EG_KT(1) * kB : cB + EG_KT(t + 3) * kB;
            if constexpr (Epi::HAS_MID) { if (t == g.mid) E.mid(acc, cur, wr, wc, fr, fq, ui, 0); else if (t == g.mid2) E.mid(acc, cur, wr, wc, fr, fq, ui, 1); }
            if constexpr (Sched::WAITS) { if (last && has_next) S.a_ready(nxt, tid); }
            EG_LDB(B0, 0, 0); if constexpr (!Epi::ONLY_B0) EG_LDB(B1, 0, 1); EG_SCHED; EG_LDA(At, 0, 0); EG_STAGE(EG_SA(1, 1), a1, cv[1][0], cv[1][1]);
            EG_WAIT_V(8); EG_WAIT_L(0); EG_BAR; EG_MMA(0, 0, At, B0); if constexpr (!Epi::ONLY_B0) EG_MMA(0, 1, At, B1); EG_BAR; EG_SCHED;
            EG_LDA(At, 0, 1); EG_STB(EG_SB(0, 0), b2); EG_STB(EG_SB(0, 1), b2 + hstepB); EG_STAGE(EG_SA(0, 0), a2, EG_SV(0, 0), EG_SV(0, 1));
            EG_WAIT_V(8);
            if constexpr (Epi::PUBLISH) { if (pub >= 0) { E.publish(pub, lane); pub = -1; } }
            EG_WAIT_L(0); EG_BAR; EG_MMA(1, 0, At, B0); if constexpr (!Epi::ONLY_B0) EG_MMA(1, 1, At, B1); EG_BAR; EG_SCHED;
            EG_LDB(B0, 1, 0); if constexpr (!Epi::ONLY_B0) EG_LDB(B1, 1, 1); EG_SCHED; EG_LDA(At, 1, 0); EG_STAGE(EG_SA(0, 1), a2, EG_SV(1, 0), EG_SV(1, 1));
            EG_WAIT_V(8); EG_WAIT_L(0); EG_BAR; EG_MMA(0, 0, At, B0); if constexpr (!Epi::ONLY_B0) EG_MMA(0, 1, At, B1); EG_BAR; EG_SCHED;
            EG_LDA(At, 1, 1); EG_STB(EG_SB(1, 0), b3); EG_STB(EG_SB(1, 1), b3 + hstepB); EG_STAGE(EG_SA(1, 0), a3, EG_SV(0, 0), EG_SV(0, 1));
            EG_WAIT_V(8); EG_WAIT_L(0); EG_BAR; EG_MMA(1, 0, At, B0); if constexpr (!Epi::ONLY_B0) EG_MMA(1, 1, At, B1); EG_BAR; EG_SCHED;
        }
        if (wr == 0) EG_BAR;
        { int fr2 = fr, fq2 = fq; Unit ue = cur; asm volatile("" : "+v"(fr2), "+v"(fq2), "+s"(ue.pm), "+s"(ue.pn), "+s"(ue.e), "+s"(ue.aux)); if constexpr (Epi::HAS_MID) E(acc, ue, wr, wc, fr2, fq2, ui); else E(acc, ue, wr, wc, fr2, fq2); }
        if constexpr (Epi::PUBLISH) pub = cur.aux;
        if (!has_next) break;
#pragma unroll
        for (int a = 0; a < 2; ++a)
#pragma unroll
            for (int b = 0; b < 2; ++b)
#pragma unroll
                for (int m = 0; m < 4; ++m)
#pragma unroll
                    for (int n = 0; n < 2; ++n) acc[a][b][m][n] = (f32x4){0.f, 0.f, 0.f, 0.f};
        cur = nxt; cA = nA; cB = nB; ++ui;
        if constexpr (Sched::GATHER) {
#pragma unroll
            for (int h = 0; h < 2; ++h)
#pragma unroll
                for (int i = 0; i < 2; ++i) cv[h][i] = nv[h][i];
        }
        if (wr == 1) EG_BAR;
    }
    EG_WAIT_V(0);
    if constexpr (Epi::PUBLISH) { if (pub >= 0) E.publish(pub, lane); }
    EG_BAR;
    if constexpr (Epi::AFTER_DRAIN) E.fused(acc, cur, lds, tid, wr, wc, fr, fq);
#undef EG_SA
#undef EG_SV
#undef EG_KT
#undef EG_SB
#undef EG_STAGE
#undef EG_STB
#undef EG_LDA
#undef EG_LDB
#undef EG_MMA
#undef EG_WAIT_V
#undef EG_WAIT_L
#undef EG_BAR
#undef EG_SCHED
}
struct DenseOrder {
    int nM, nN, nwg, G, c; unsigned lda, ldb;
    __device__ __forceinline__ void init(int M, int N, int G_, int c_, unsigned lda_, unsigned ldb_) { nM = M / BM; nN = N / BM; nwg = nM * nN; G = G_; c = c_; lda = lda_; ldb = ldb_; }
    __device__ __forceinline__ bool next(int i, Unit& u) const {
        const long L = (long)i * G + c; if (L >= nwg) return false;
        int wgid = (int)L; { const int q = nwg / NXCD, r = nwg % NXCD, xcd = wgid % NXCD, off = wgid / NXCD; wgid = (xcd < r ? xcd * (q + 1) : r * (q + 1) + (xcd - r) * q) + off; }
        const int nig = WGM * nN, gid = wgid / nig, fm = gid * WGM, gsz = (nM - fm) < WGM ? (nM - fm) : WGM;
        u.pm = fm + ((wgid % nig) % gsz); u.pn = (wgid % nig) / gsz; u.e = 0; u.aux = 0;
        u.ao = (unsigned)u.pm * BM * lda; u.bo = (unsigned)u.pn * BM * ldb; return true;
    }
    __device__ __forceinline__ void a_off(const Unit&, int tid, unsigned (&v)[2][2]) const {
#pragma unroll
        for (int i = 0; i < 2; ++i) { int R, C; stage_rc(tid * 16 + i * 8192, R, C);
#pragma unroll
            for (int h = 0; h < 2; ++h) v[h][i] = (unsigned)(h * 128 + R) * lda + (unsigned)C * 2u; } }
    static constexpr bool GATHER = false, WAITS = false, KSKIP = false;
    __device__ __forceinline__ void a_ready(const eng::Unit&, int) const {}
};
}

__device__ __forceinline__ void transpose_item(const float* W, int ldw, h16* WT, int ldt, const float* ks, LAS float* scr, int k0, int n0, int drow0, int lane, float* wmax = nullptr) {
    const int nq = lane & 15, kr = lane >> 4;
    f32x4 v[16];
#pragma unroll
    for (int i = 0; i < 16; ++i) v[i] = __builtin_nontemporal_load((const f32x4*)(W + (size_t)(k0 + 4 * i + kr) * ldw + n0 + 4 * nq));
    if (ks) {
#pragma unroll
        for (int i = 0; i < 16; ++i) v[i] = v[i] * ks[k0 + 4 * i + kr]; }
    if (wmax) {
        f32x4 m = {0.f, 0.f, 0.f, 0.f};
#pragma unroll
        for (int i = 0; i < 16; ++i)
#pragma unroll
            for (int e = 0; e < 4; ++e) m[e] = fmaxf(m[e], fabsf(v[i][e]));
#pragma unroll
        for (int e = 0; e < 4; ++e) { float x = m[e];
            x = fmaxf(x, __builtin_bit_cast(float, __builtin_amdgcn_ds_bpermute((lane ^ 16) << 2, __builtin_bit_cast(int, x))));
            x = fmaxf(x, __builtin_bit_cast(float, __builtin_amdgcn_ds_bpermute((lane ^ 32) << 2, __builtin_bit_cast(int, x))));
            if (kr == 0) atomicMax((unsigned*)(wmax + drow0 + 4 * nq + e), __float_as_uint(x)); } }
#pragma unroll
    for (int i = 0; i < 16; ++i) { LAS float* d = scr + (4 * i + kr) * 65 + 4 * nq; d[0] = v[i][0]; d[1] = v[i][1]; d[2] = v[i][2]; d[3] = v[i][3]; }
    asm volatile("s_waitcnt lgkmcnt(0)" ::: "memory");
#pragma unroll
    for (int j = 0; j < 8; ++j) { const int id = lane + 64 * j, cc = id & 7, n = id >> 3; const LAS float* s = scr + (8 * cc) * 65 + n;
        u32x4 o; o.x = pk_h16(s[0 * 65], s[1 * 65]); o.y = pk_h16(s[2 * 65], s[3 * 65]); o.z = pk_h16(s[4 * 65], s[5 * 65]); o.w = pk_h16(s[6 * 65], s[7 * 65]);
        __builtin_nontemporal_store(o, (u32x4*)(WT + (size_t)(drow0 + n) * ldt + k0 + 8 * cc)); }
    asm volatile("s_waitcnt lgkmcnt(0)" ::: "memory");
}

__device__ __forceinline__ void absmax_item(const float* W, int ldw, const float* ks, float* wmax, int k0, int n0, int drow0, int lane) {
    const int nq = lane & 15, kr = lane >> 4;
    f32x4 v[16];
#pragma unroll
    for (int i = 0; i < 16; ++i) v[i] = *(const f32x4*)(W + (size_t)(k0 + 4 * i + kr) * ldw + n0 + 4 * nq);
    f32x4 m = {0.f, 0.f, 0.f, 0.f};
#pragma unroll
    for (int i = 0; i < 16; ++i) { const float g = ks[k0 + 4 * i + kr];
#pragma unroll
        for (int e = 0; e < 4; ++e) m[e] = fmaxf(m[e], fabsf(v[i][e] * g)); }
#pragma unroll
    for (int e = 0; e < 4; ++e) { float x = m[e];
        x = fmaxf(x, __builtin_bit_cast(float, __builtin_amdgcn_ds_bpermute((lane ^ 16) << 2, __builtin_bit_cast(int, x))));
        x = fmaxf(x, __builtin_bit_cast(float, __builtin_amdgcn_ds_bpermute((lane ^ 32) << 2, __builtin_bit_cast(int, x))));
        if (kr == 0) atomicMax((unsigned*)(wmax + drow0 + 4 * nq + e), __float_as_uint(x)); }
}
__device__ __forceinline__ void transpose_item_q8(const float* W, int ldw, unsigned char* WT8, int ldt, const float* ks, const float* wmax, LAS float* scr, int k0, int n0, int drow0, int lane, bool s5perm = false) {
    const int nq = lane & 15, kr = lane >> 4;
    f32x4 v[16];
#pragma unroll
    for (int i = 0; i < 16; ++i) v[i] = __builtin_nontemporal_load((const f32x4*)(W + (size_t)(k0 + 4 * i + kr) * ldw + n0 + 4 * nq));
#pragma unroll
    for (int i = 0; i < 16; ++i) v[i] = v[i] * ks[k0 + 4 * i + kr];
#pragma unroll
    for (int i = 0; i < 16; ++i) { LAS float* d = scr + (4 * i + kr) * 65 + 4 * nq; d[0] = v[i][0]; d[1] = v[i][1]; d[2] = v[i][2]; d[3] = v[i][3]; }
    asm volatile("s_waitcnt lgkmcnt(0)" ::: "memory");
#pragma unroll
    for (int j = 0; j < 4; ++j) { const int id = lane + 64 * j, cc = id & 3, n = id >> 2; const LAS float* sp = scr + (16 * cc) * 65 + n;
        const float wm = wmax[drow0 + n], inv = wm > 1e-30f ? 127.0f / wm : 0.f;
        u32x4 o; o.x = pk_i8(sp[0 * 65], sp[1 * 65], sp[2 * 65], sp[3 * 65], inv); o.y = pk_i8(sp[4 * 65], sp[5 * 65], sp[6 * 65], sp[7 * 65], inv);
        o.z = pk_i8(sp[8 * 65], sp[9 * 65], sp[10 * 65], sp[11 * 65], inv); o.w = pk_i8(sp[12 * 65], sp[13 * 65], sp[14 * 65], sp[15 * 65], inv);
        if (s5perm && k0 >= CW) {
            const int kk = k0 - CW + 16 * cc, pos = CW + (kk & 256) + ((kk >> 5) & 3) * 64 + ((kk >> 3) & 3) * 16 + ((kk >> 7) & 1) * 8; unsigned char* rp = WT8 + (size_t)(drow0 + n) * ldt + pos;
            u32x2 lo, hi; lo.x = o.x; lo.y = o.y; hi.x = o.z; hi.y = o.w; *(u32x2*)rp = lo; *(u32x2*)(rp + 16) = hi; }
        else *(u32x4*)(WT8 + (size_t)(drow0 + n) * ldt + k0 + 16 * cc) = o; }
    asm volatile("s_waitcnt lgkmcnt(0)" ::: "memory");
}

struct MoeBase {
    const LAS int* tb; int G, c, T; bool flip = false; int tlim = 1 << 30, tail0 = -1;
    __device__ __forceinline__ bool locate(int i, eng::Unit& u) const {
        int tile, pn;
        if (tail0 >= 0) { const int jj = c >> 3; tile = tail0 + i * (G >> 2) + (c & 7) * (G >> 5) + (jj >> 2); pn = jj & 3; }
        else if ((G & 31) == 0) { const int TR = G >> 2, x = flip ? 7 - (c & 7) : (c & 7), j = c >> 3; tile = i * TR + x * (TR >> 3) + (j >> 2); pn = j & 3; }
        else { const long L = (long)i * G + c; tile = (int)(L >> 2); pn = (int)(L & 3); }
        if (tile >= T || (tail0 < 0 && tile >= tlim)) return false;
        int ln; asm volatile("v_mbcnt_lo_u32_b32 %0, -1, 0\n\tv_mbcnt_hi_u32_b32 %0, -1, %0" : "=v"(ln));
        const unsigned long long mk = __ballot(ln < NE && tile >= tb[ln & 31]);
        const int e = __builtin_popcountll(mk) - 1; u.e = e; u.pm = __builtin_amdgcn_readfirstlane(tile - tb[e]); u.pn = pn; u.aux = tile; return true;
    }
};
struct MoeGU : MoeBase {
    const unsigned* list;
    __device__ __forceinline__ bool next(int i, eng::Unit& u) const { if (!locate(i, u)) return false; u.ao = 0u; u.bo = ((unsigned)u.e * 1024u + (unsigned)u.pn * 256u) * 1024u; return true; }
    static constexpr bool GATHER = true, WAITS = false, KSKIP = false;
    __device__ __forceinline__ void a_ready(const eng::Unit&, int) const {}
    __device__ __forceinline__ void a_off(const eng::Unit& u, int tid, unsigned (&v)[2][2]) const {
        const int cn = __builtin_amdgcn_readfirstlane(tb[40 + u.e]); const unsigned* le = list + (size_t)u.e * NTOK * 4;
#pragma unroll
        for (int i = 0; i < 2; ++i) { int R, C; eng::stage_rc(tid * 16 + i * 8192, R, C);
#pragma unroll
            for (int h = 0; h < 2; ++h) { int p = u.pm * 256 + h * 128 + R; p = p < cn ? p : cn - 1; const int tok = (int)(le[p * 4] >> 1); v[h][i] = (unsigned)tok * 1024u + (unsigned)C * 2u; } }
    }
};
struct MoeDown : MoeBase {
    unsigned* tc; unsigned* tmo;
    __device__ __forceinline__ bool next(int i, eng::Unit& u) const { if (!locate(i, u)) return false; u.ao = (unsigned)u.aux * 256u * 1024u; u.bo = ((unsigned)u.e * 1024u + (unsigned)u.pn * 256u) * 1024u; return true; }
    __device__ __forceinline__ void a_off(const eng::Unit&, int tid, unsigned (&v)[2][2]) const {
#pragma unroll
        for (int i = 0; i < 2; ++i) { int R, C; eng::stage_rc(tid * 16 + i * 8192, R, C);
#pragma unroll
            for (int h = 0; h < 2; ++h) v[h][i] = (unsigned)(h * 128 + R) * 1024u + (unsigned)C * 2u; } }
    static constexpr bool GATHER = false, WAITS = true, KSKIP = false;
    __device__ __forceinline__ void a_ready(const eng::Unit& u, int tid) const {
        if (tid < 64) {
            unsigned* w = tc + (size_t)u.aux * 64; unsigned sp = 0u;
            while ((unsigned)__builtin_amdgcn_readfirstlane((int)__hip_atomic_load(w, __ATOMIC_RELAXED, __HIP_MEMORY_SCOPE_AGENT)) < 32u) {
                __builtin_amdgcn_s_sleep(2);
                if ((++sp & 255u) == 0u) { if (__hip_atomic_load(tmo, __ATOMIC_RELAXED, __HIP_MEMORY_SCOPE_AGENT) != 0u) break; if (sp > (1u << 22)) { if (tid == 0) __hip_atomic_store(tmo, 1u, __ATOMIC_RELAXED, __HIP_MEMORY_SCOPE_AGENT); break; } } }
            __builtin_amdgcn_fence(__ATOMIC_ACQUIRE, "agent");
            asm volatile("s_waitcnt vmcnt(0)" ::: "memory");
        }
        asm volatile("" ::: "memory"); __builtin_amdgcn_s_barrier(); asm volatile("" ::: "memory");
    }
};
__device__ __forceinline__ float fsigmoid(float x) { return __builtin_amdgcn_rcpf(1.0f + __expf(-x)); }
struct EpiHid {
    static constexpr bool PERM = true, HAS_MID = false, AFTER_DRAIN = false, PUBLISH = true, ONLY_B0 = false, I8 = true;
    h16* HID; const unsigned* list; const LAS int* tb; unsigned* tc; const float* WME;
    __device__ __forceinline__ void operator()(const f32x4 (&acc)[2][2][4][2], const eng::Unit& u, int wr, int wc, int fr, int fq) const {
        f32x4 cw[2][2];
#pragma unroll
        for (int bj = 0; bj < 2; ++bj)
#pragma unroll
            for (int n = 0; n < 2; ++n) cw[bj][n] = *(const f32x4*)(WME + (size_t)u.e * 1024 + u.pn * 256 + bj * 128 + wc * 32 + 8 * fq + 4 * n);
        const int cn = __builtin_amdgcn_readfirstlane(tb[40 + u.e]); const unsigned* le = list + (size_t)u.e * NTOK * 4; const int col0 = u.pn * 128 + wc * 32 + 8 * fq;
        float rr[8];
#pragma unroll
        for (int q = 0; q < 8; ++q) { int p = u.pm * 256 + (q >> 2) * 128 + wr * 64 + (q & 3) * 16 + fr; p = p < cn ? p : cn - 1; const unsigned rb = le[p * 4 + 2]; rr[q] = __uint_as_float(rb); }
#pragma unroll
        for (int ai = 0; ai < 2; ++ai)
#pragma unroll
            for (int m = 0; m < 4; ++m) { const int r = ai * 128 + wr * 64 + m * 16 + fr; const float rs = rr[ai * 4 + m]; float o[8];
#pragma unroll
                for (int n = 0; n < 2; ++n) { const i32x4 ig = __builtin_bit_cast(i32x4, acc[ai][0][m][n]), iu = __builtin_bit_cast(i32x4, acc[ai][1][m][n]);
                    const f32x4 gv = (f32x4){(float)ig[0], (float)ig[1], (float)ig[2], (float)ig[3]} * (cw[0][n] * rs), uv = (f32x4){(float)iu[0], (float)iu[1], (float)iu[2], (float)iu[3]} * (cw[1][n] * rs);
#pragma unroll
                    for (int j = 0; j < 4; ++j) { const float g = gv[j], uu = uv[j]; o[n * 4 + j] = g * fsigmoid(g) * uu; } }
                u32x4 w; w.x = pk_h16(o[0], o[1]); w.y = pk_h16(o[2], o[3]); w.z = pk_h16(o[4], o[5]); w.w = pk_h16(o[6], o[7]);
                asm volatile("global_store_dwordx4 %0, %1, off sc1\n\ts_nop 1" :: "v"((GAS u32x4*)(HID + ((size_t)u.aux * 256 + r) * 512 + col0)), "v"(w) : "memory"); }
    }
    __device__ __forceinline__ void publish(int tile, int lane) const { if (lane == 0) __hip_atomic_fetch_add(tc + (size_t)tile * 64, 1u, __ATOMIC_RELAXED, __HIP_MEMORY_SCOPE_AGENT); }
};
struct EpiScat {
    static constexpr bool PERM = true, HAS_MID = false, AFTER_DRAIN = false, PUBLISH = false, ONLY_B0 = false, I8 = false;
    unsigned char* ys8; float* sc; const unsigned* list; const LAS int* tb;
    __device__ __forceinline__ void operator()(const f32x4 (&acc)[2][2][4][2], const eng::Unit& u, int wr, int wc, int fr, int fq) const {
        const int cn = __builtin_amdgcn_readfirstlane(tb[40 + u.e]); const unsigned* le = list + (size_t)u.e * NTOK * 4; const int col0 = u.pn * 256 + wc * 32 + 8 * fq; const int lane = fr + 16 * fq;
        int ent[8]; float gt[8];
#pragma unroll
        for (int q = 0; q < 8; ++q) { int p = u.pm * 256 + (q >> 2) * 128 + wr * 64 + (q & 3) * 16 + fr; p = p < cn ? p : cn - 1; const u32x2 rc = *(const u32x2*)(le + p * 4); const unsigned r0 = rc[0], r1 = rc[1]; ent[q] = (int)r0; gt[q] = __uint_as_float(r1); }
#pragma unroll
        for (int ai = 0; ai < 2; ++ai)
#pragma unroll
            for (int m = 0; m < 4; ++m) { const int p = u.pm * 256 + ai * 128 + wr * 64 + m * 16 + fr; const float g = gt[ai * 4 + m];
                const f32x4 a0 = acc[ai][0][m][0] * g, b0 = acc[ai][0][m][1] * g, a1 = acc[ai][1][m][0] * g, b1 = acc[ai][1][m][1] * g;
                float am = fmaxf(fmaxf(fmaxf(fabsf(a0[0]), fabsf(a0[1])), fmaxf(fabsf(a0[2]), fabsf(a0[3]))), fmaxf(fmaxf(fabsf(b0[0]), fabsf(b0[1])), fmaxf(fabsf(b0[2]), fabsf(b0[3]))));
                am = fmaxf(am, fmaxf(fmaxf(fmaxf(fabsf(a1[0]), fabsf(a1[1])), fmaxf(fabsf(a1[2]), fabsf(a1[3]))), fmaxf(fmaxf(fabsf(b1[0]), fabsf(b1[1])), fmaxf(fabsf(b1[2]), fabsf(b1[3])))));
                am = fmaxf(am, __builtin_bit_cast(float, __builtin_amdgcn_ds_bpermute((lane ^ 16) << 2, __builtin_bit_cast(int, am))));
                am = fmaxf(am, __builtin_bit_cast(float, __builtin_amdgcn_ds_bpermute((lane ^ 32) << 2, __builtin_bit_cast(int, am))));
                const float inv = am > 1e-30f ? 127.0f / am : 0.f;
                if (p < cn) { unsigned char* rowp = ys8 + (size_t)ent[ai * 4 + m] * DM + u.pn * 256 + wc * 64 + fq * 16;
                    u32x4 w; w.x = pk_u8o(a0[0], a0[1], a0[2], a0[3], inv); w.y = pk_u8o(b0[0], b0[1], b0[2], b0[3], inv); w.z = pk_u8o(a1[0], a1[1], a1[2], a1[3], inv); w.w = pk_u8o(b1[0], b1[1], b1[2], b1[3], inv);
                    __builtin_nontemporal_store(w, (u32x4*)rowp);
                    if (fq == 0) sc[(size_t)ent[ai * 4 + m] * 16 + u.pn * 4 + wc] = am * (1.0f / 127.0f); } }
    }
};

constexpr float SSM_SCALE = 1024.0f, SSM_ISCALE = 1.0f / 1024.0f;
constexpr int TCH = 32, NCH = SEQ / TCH;
__device__ __forceinline__ float gelu_fast(float x) { return x * fsigmoid(1.5957691216057308f * (x + 0.044715f * x * x * x)); }
struct EpiIn {
    static constexpr bool PERM = true, HAS_MID = false, AFTER_DRAIN = false, PUBLISH = false, ONLY_B0 = false, I8 = true;
    h16* U; h16* SG; const float* RR0; const float* WMAX;
    __device__ __forceinline__ void operator()(const f32x4 (&acci)[2][2][4][2], const eng::Unit& u, int wr, int wc, int fr, int fq) const {
        float rr[8];
#pragma unroll
        for (int q = 0; q < 8; ++q) rr[q] = RR0[u.pm * 256 + (q >> 2) * 128 + wr * 64 + (q & 3) * 16 + fr];
        f32x4 cw[2][2];
#pragma unroll
        for (int bj = 0; bj < 2; ++bj)
#pragma unroll
            for (int n = 0; n < 2; ++n) cw[bj][n] = *(const f32x4*)(WMAX + u.pn * 256 + bj * 128 + wc * 32 + 8 * fq + 4 * n);
#define EI_CV(ai, bj, m, n) ({ const i32x4 iv_ = __builtin_bit_cast(i32x4, acci[ai][bj][m][n]); (f32x4){(float)iv_[0], (float)iv_[1], (float)iv_[2], (float)iv_[3]} * cw[bj][n]; })
        if (u.pn < 4) {
            const int col0 = u.pn * 128 + wc * 32 + 8 * fq;
#pragma unroll
            for (int ai = 0; ai < 2; ++ai)
#pragma unroll
                for (int m = 0; m < 4; ++m) { const int tok = u.pm * 256 + ai * 128 + wr * 64 + m * 16 + fr; const float rs = rr[ai * 4 + m]; float o[8];
#pragma unroll
                    for (int n = 0; n < 2; ++n) { const f32x4 va = EI_CV(ai, 0, m, n), ga = EI_CV(ai, 1, m, n);
#pragma unroll
                        for (int j = 0; j < 4; ++j) o[n * 4 + j] = va[j] * rs * fsigmoid(ga[j] * rs); }
                    u32x4 w; w.x = pk_h16(o[0], o[1]); w.y = pk_h16(o[2], o[3]); w.z = pk_h16(o[4], o[5]); w.w = pk_h16(o[6], o[7]);
                    *(u32x4*)(U + (size_t)tok * CW + col0) = w; }
        } else {
#pragma unroll
            for (int bj = 0; bj < 2; ++bj) { const int ch = (u.pn - 4) * 256 + bj * 128 + wc * 32 + 8 * fq, g = ch >> 4, c0 = ch & 15;
#pragma unroll
                for (int ai = 0; ai < 2; ++ai)
#pragma unroll
                    for (int m = 0; m < 4; ++m) { const int tok = u.pm * 256 + ai * 128 + wr * 64 + m * 16 + fr; const f32x4 a = EI_CV(ai, bj, m, 0) * rr[ai * 4 + m], b = EI_CV(ai, bj, m, 1) * rr[ai * 4 + m];
                        u32x4 w; w.x = pk_h16(a[0], a[1]); w.y = pk_h16(a[2], a[3]); w.z = pk_h16(b[0], b[1]); w.w = pk_h16(b[2], b[3]);
                        *(u32x4*)(SG + ((size_t)g * 1024 + (tok >> 5)) * 640 + (tok & 31) * 16 + c0) = w; } }
        }
#undef EI_CV
    }
};
struct SsmSOrder {
    int G, c;
    static __device__ __forceinline__ int unit_of(int G, int c) { if (G == 256) return (c >> 3) < 16 ? (c & 7) * 16 + (c >> 3) : -1; return c < NG * 4 ? c : -1; }
    __device__ __forceinline__ bool next(int i, eng::Unit& u) const {
        const int L = unit_of(G, c); if (i > 0 || L < 0) return false;
        u.e = L >> 2; u.pm = L & 3; u.pn = 0; u.aux = 0; u.ao = ((unsigned)u.e * 1024u + (unsigned)u.pm * 256u) * 1280u; u.bo = (unsigned)u.e * 256u * 1024u; return true; }
    __device__ __forceinline__ void a_off(const eng::Unit&, int tid, unsigned (&v)[2][2]) const {
#pragma unroll
        for (int i = 0; i < 2; ++i) { int R, C; eng::stage_rc(tid * 16 + i * 8192, R, C);
#pragma unroll
            for (int h = 0; h < 2; ++h) v[h][i] = (unsigned)(h * 128 + R) * 1280u + (unsigned)C * 2u; } }
    static constexpr bool GATHER = false, WAITS = false, KSKIP = false;
    __device__ __forceinline__ void a_ready(const eng::Unit&, int) const {}
};
struct EpiS {
    static constexpr bool PERM = false, HAS_MID = false, AFTER_DRAIN = true, PUBLISH = false, ONLY_B0 = true, I8 = false;
    h16* SG; const float* AT;
    __device__ __forceinline__ void operator()(const f32x4 (&)[2][2][4][2], const eng::Unit&, int, int, int, int) const {}
    __device__ __forceinline__ void fused(const f32x4 (&acc)[2][2][4][2], const eng::Unit& u, LAS unsigned char* lds, int tid, int wr, int wc, int fr, int fq) const {
        LAS float* Sl = (LAS float*)lds;
#pragma unroll
        for (int ai = 0; ai < 2; ++ai)
#pragma unroll
            for (int m = 0; m < 4; ++m)
#pragma unroll
                for (int n = 0; n < 2; ++n) *(LAS f32x4*)(Sl + (ai * 128 + wr * 64 + m * 16 + fr) * 132 + wc * 32 + n * 16 + 4 * fq) = acc[ai][0][m][n] * SSM_ISCALE;
        __syncthreads();
        if (tid < 256) { const int bl = tid >> 6, n = tid & 63; const float are = AT[(u.e * NS + n) * 2], aim = AT[(u.e * NS + n) * 2 + 1]; float hr = 0.f, hi2 = 0.f;
            h16* sg = SG + ((size_t)u.e * 1024 + u.pm * 256 + bl * 64) * 640;
#pragma unroll 8
            for (int j = 0; j < NCH; ++j) { sg[(size_t)j * 640 + 512 + n] = (h16)hr; sg[(size_t)j * 640 + 576 + n] = (h16)hi2;
                const float sr = Sl[(bl * 64 + j) * 132 + n], si = Sl[(bl * 64 + j) * 132 + 64 + n]; const float nr = are * hr - aim * hi2 + sr, ni = are * hi2 + aim * hr + si; hr = nr; hi2 = ni; } }
        asm volatile("s_waitcnt vmcnt(0)" ::: "memory");
        __syncthreads();
    }
};
struct SsmYOrder {
    int G, c;
    __device__ __forceinline__ bool next(int i, eng::Unit& u) const {
        const int L = i * G + ((G & 7) == 0 ? (c & 7) * (G >> 3) + (c >> 3) : c); if (L >= NG * 8) return false;
        u.e = L >> 3; u.pm = (L >> 1) & 3; u.pn = L & 1; u.aux = 0; u.ao = ((unsigned)u.e * 1024u + (unsigned)u.pm * 256u) * 1280u; u.bo = ((unsigned)u.e * 512u + (unsigned)u.pn * 256u) * 1280u; return true; }
    __device__ __forceinline__ void a_off(const eng::Unit&, int tid, unsigned (&v)[2][2]) const {
#pragma unroll
        for (int i = 0; i < 2; ++i) { int R, C; eng::stage_rc(tid * 16 + i * 8192, R, C);
#pragma unroll
            for (int h = 0; h < 2; ++h) v[h][i] = (unsigned)(h * 128 + R) * 1280u + (unsigned)C * 2u; } }
    static constexpr bool GATHER = false, WAITS = false, KSKIP = false;
    __device__ __forceinline__ void a_ready(const eng::Unit&, int) const {}
};
struct SsmYLocal : SsmYOrder {
    __device__ __forceinline__ bool next(int i, eng::Unit& u) const {
        const int L = SsmSOrder::unit_of(G, c); if (i > 1 || L < 0) return false;
        u.e = L >> 2; u.pm = L & 3; u.pn = i; u.aux = 0; u.ao = ((unsigned)u.e * 1024u + (unsigned)u.pm * 256u) * 1280u; u.bo = ((unsigned)u.e * 512u + (unsigned)u.pn * 256u) * 1280u;
        u.nt = i == 0 ? 6 : 10; u.kcut = i == 0 ? 4 : 1 << 20; u.kskip = i == 0 ? 4 : 0; return true; }
    static constexpr bool KSKIP = true;
};
struct EpiY {
    static constexpr bool PERM = true, HAS_MID = false, AFTER_DRAIN = false, PUBLISH = false, ONLY_B0 = false, I8 = false;
    const h16* SG; const float* dco; h16* VG;
    __device__ __forceinline__ void operator()(const f32x4 (&acc)[2][2][4][2], const eng::Unit& u, int wr, int wc, int fr, int fq) const {
#pragma unroll
        for (int bj = 0; bj < 2; ++bj) { const int col0 = u.pn * 256 + bj * 128 + wc * 32 + 8 * fq, c0 = col0 & 15;
            const f32x4 d0 = *(const f32x4*)(dco + u.e * 16 + c0), d1 = *(const f32x4*)(dco + u.e * 16 + c0 + 4);
            h16x8 uv[8];
#pragma unroll
            for (int q = 0; q < 8; ++q) uv[q] = *(const h16x8*)(SG + ((size_t)u.e * 1024 + u.pm * 256 + (q >> 2) * 128 + wr * 64 + (q & 3) * 16 + fr) * 640 + col0);
#pragma unroll
            for (int ai = 0; ai < 2; ++ai)
#pragma unroll
                for (int m = 0; m < 4; ++m) { const int row = u.pm * 256 + ai * 128 + wr * 64 + m * 16 + fr; const h16x8 x = uv[ai * 4 + m];
                    float o[8];
#pragma unroll
                    for (int j = 0; j < 4; ++j) { o[j] = gelu_fast(acc[ai][bj][m][0][j] * SSM_ISCALE + d0[j] * (float)x[j]); o[4 + j] = gelu_fast(acc[ai][bj][m][1][j] * SSM_ISCALE + d1[j] * (float)x[4 + j]); }
                    u32x4 w; w.x = pk_h16(o[0], o[1]); w.y = pk_h16(o[2], o[3]); w.z = pk_h16(o[4], o[5]); w.w = pk_h16(o[6], o[7]);
                    *(u32x4*)(VG + ((size_t)u.e * 1024 + row) * 512 + col0) = w; } }
    }
};
struct GluOrder : eng::DenseOrder {
    static constexpr bool GATHER = false, WAITS = false, KSKIP = false;
    __device__ __forceinline__ void a_ready(const eng::Unit&, int) const {}
    __device__ __forceinline__ bool next(int i, eng::Unit& u) const { if (!eng::DenseOrder::next(i, u)) return false; u.ao = (unsigned)u.pm * 256u * 32u; return true; }
    __device__ __forceinline__ void a_off(const eng::Unit&, int tid, unsigned (&v)[2][2]) const {
#pragma unroll
        for (int i = 0; i < 2; ++i) { int R, C; eng::stage_rc(tid * 16 + i * 8192, R, C);
#pragma unroll
            for (int h = 0; h < 2; ++h) v[h][i] = (unsigned)(h * 128 + R) * 32u + (unsigned)(C >> 4) * (unsigned)(NTOK * 32) + (unsigned)(C & 15) * 2u; } }
};
__device__ __forceinline__ float xor_add(float v, int lane, int m) { return v + __builtin_bit_cast(float, __builtin_amdgcn_ds_bpermute((lane ^ m) << 2, __builtin_bit_cast(int, v))); }
struct EpiGlu {
    static constexpr bool PERM = true, HAS_MID = false, AFTER_DRAIN = false, PUBLISH = false, ONLY_B0 = false, I8 = false;
    const h16* VG; const float* bias; unsigned char* YH8; float* SSQ2; float* SIGS; LAS unsigned char* lds;
    __device__ __forceinline__ void operator()(const f32x4 (&acc)[2][2][4][2], const eng::Unit& u, int wr, int wc, int fr, int fq) const {
        const int lane = fr + 16 * fq; LAS float* sx = (LAS float*)(lds + 131584);
        f32x4 bv[2][2];
#pragma unroll
        for (int bj = 0; bj < 2; ++bj)
#pragma unroll
            for (int n = 0; n < 2; ++n) bv[bj][n] = *(const f32x4*)(bias + u.pn * 256 + bj * 128 + wc * 32 + 8 * fq + 4 * n);
        unsigned yh[2][4][8];
#pragma unroll
        for (int ai = 0; ai < 2; ++ai) {
            h16x8 vv[4][2];
#pragma unroll
            for (int m = 0; m < 4; ++m)
#pragma unroll
                for (int bj = 0; bj < 2; ++bj) { const int tok = u.pm * 256 + ai * 128 + wr * 64 + m * 16 + fr, ch0 = u.pn * 256 + bj * 128 + wc * 32 + 8 * fq;
                    vv[m][bj] = *(const h16x8*)(VG + (size_t)(ch0 >> 4) * (NTOK * 16) + (size_t)tok * 16 + (ch0 & 15)); }
#pragma unroll
            for (int m = 0; m < 4; ++m) { const int tok = u.pm * 256 + ai * 128 + wr * 64 + m * 16 + fr; float ss = 0.f, am = 0.f;
#pragma unroll
                for (int bj = 0; bj < 2; ++bj) { float o[8];
#pragma unroll
                    for (int n = 0; n < 2; ++n)
#pragma unroll
                        for (int j = 0; j < 4; ++j) { const float y = (float)vv[m][bj][n * 4 + j] * fsigmoid(acc[ai][bj][m][n][j] + bv[bj][n][j]); o[n * 4 + j] = y; ss += y * y; am = fmaxf(am, fabsf(y)); }
                    yh[ai][m][bj * 4 + 0] = pk_h16(o[0], o[1]); yh[ai][m][bj * 4 + 1] = pk_h16(o[2], o[3]); yh[ai][m][bj * 4 + 2] = pk_h16(o[4], o[5]); yh[ai][m][bj * 4 + 3] = pk_h16(o[6], o[7]); }
                ss = xor_add(ss, lane, 16); ss = xor_add(ss, lane, 32);
                am = fmaxf(am, __builtin_bit_cast(float, __builtin_amdgcn_ds_bpermute((lane ^ 16) << 2, __builtin_bit_cast(int, am))));
                am = fmaxf(am, __builtin_bit_cast(float, __builtin_amdgcn_ds_bpermute((lane ^ 32) << 2, __builtin_bit_cast(int, am))));
                if (fq == 0) { SSQ2[(size_t)tok * 8 + u.pn * 4 + wc] = ss; sx[(ai * 128 + wr * 64 + m * 16 + fr) * 4 + wc] = am; } } }
        asm volatile("s_waitcnt lgkmcnt(0)" ::: "memory"); __builtin_amdgcn_s_barrier(); asm volatile("" ::: "memory");
#pragma unroll
        for (int ai = 0; ai < 2; ++ai)
#pragma unroll
            for (int m = 0; m < 4; ++m) { const int r = ai * 128 + wr * 64 + m * 16 + fr, tok = u.pm * 256 + r; const f32x4 s4 = *(const LAS f32x4*)(sx + r * 4);
                const float rm = fmaxf(fmaxf(s4[0], s4[1]), fmaxf(s4[2], s4[3])), inv = rm > 1e-30f ? 127.0f / rm : 0.f; u32x4 w;
#pragma unroll
                for (int d = 0; d < 4; ++d) { const unsigned p0 = yh[ai][m][2 * d], p1 = yh[ai][m][2 * d + 1]; const h16x2 h0 = __builtin_bit_cast(h16x2, p0), h1 = __builtin_bit_cast(h16x2, p1);
                    const unsigned qd = pk_i8((float)h0[0], (float)h0[1], (float)h1[0], (float)h1[1], inv); if (d == 0) w.x = qd; else if (d == 1) w.y = qd; else if (d == 2) w.z = qd; else w.w = qd; }
                *(u32x4*)(YH8 + (size_t)tok * DM + CW + u.pn * 256 + wc * 64 + fq * 16) = w;
                if (wc == 0 && fq == 0) SIGS[(size_t)tok * 2 + u.pn] = rm * (1.0f / 127.0f); }
    }
};
struct EpiOut {
    static constexpr bool PERM = true, HAS_MID = true, AFTER_DRAIN = false, PUBLISH = false, ONLY_B0 = false, I8 = true;
    const h16* src; h16* dst; float* SSQ1; const float* WMAXO; LAS unsigned char* lds;
    __device__ __forceinline__ void mid(f32x4 (&acc)[2][2][4][2], const eng::Unit& u, int wr, int wc, int fr, int fq, int ui, int which) const {
        const LAS float* fac = (const LAS float*)(lds + 131584) + (size_t)(ui & 1) * 1024;
#pragma unroll
        for (int ai = 0; ai < 2; ++ai)
#pragma unroll
            for (int m = 0; m < 4; ++m) { const float rho = fac[(ai * 128 + wr * 64 + m * 16 + fr) * 4 + which];
#pragma unroll
                for (int bj = 0; bj < 2; ++bj)
#pragma unroll
                    for (int n = 0; n < 2; ++n) { const i32x4 iv = __builtin_bit_cast(i32x4, acc[ai][bj][m][n]);
                        const i32x4 ov = {(int)((float)iv[0] * rho), (int)((float)iv[1] * rho), (int)((float)iv[2] * rho), (int)((float)iv[3] * rho)};
                        acc[ai][bj][m][n] = __builtin_bit_cast(f32x4, ov); } }
    }
    __device__ __forceinline__ void operator()(const f32x4 (&acc)[2][2][4][2], const eng::Unit& u, int wr, int wc, int fr, int fq, int ui) const {
        const int lane = fr + 16 * fq; const int row0 = u.pm * 256 + wr * 64 + fr, col0 = u.pn * 256 + wc * 32 + 8 * fq;
        const LAS float* fac = (const LAS float*)(lds + 131584) + (size_t)(ui & 1) * 1024;
        h16x8 cwh[2];
#pragma unroll
        for (int bj = 0; bj < 2; ++bj) { const f32x4 c0 = *(const f32x4*)(WMAXO + col0 + bj * 128), c1 = *(const f32x4*)(WMAXO + col0 + bj * 128 + 4);
            cwh[bj] = (h16x8){(h16)c0[0], (h16)c0[1], (h16)c0[2], (h16)c0[3], (h16)c1[0], (h16)c1[1], (h16)c1[2], (h16)c1[3]}; }
#pragma unroll
        for (int ai = 0; ai < 2; ++ai) {
            h16x8 xs[4][2];
#pragma unroll
            for (int m = 0; m < 4; ++m) { const size_t o = (size_t)(row0 + ai * 128 + m * 16) * DM + col0;
#pragma unroll
                for (int bj = 0; bj < 2; ++bj) xs[m][bj] = *(const h16x8*)(src + o + bj * 128); }
#pragma unroll
            for (int m = 0; m < 4; ++m) { const int row = row0 + ai * 128 + m * 16; const size_t o = (size_t)row * DM + col0; float ss = 0.f, am = 0.f;
                const float rf = fac[(ai * 128 + wr * 64 + m * 16 + fr) * 4 + 2];
#pragma unroll
                for (int bj = 0; bj < 2; ++bj) { h16x8 hv;
#pragma unroll
                    for (int n = 0; n < 2; ++n) { const i32x4 iv = __builtin_bit_cast(i32x4, acc[ai][bj][m][n]); const f32x4 dv = (f32x4){(float)iv[0] * (float)cwh[bj][n * 4], (float)iv[1] * (float)cwh[bj][n * 4 + 1], (float)iv[2] * (float)cwh[bj][n * 4 + 2], (float)iv[3] * (float)cwh[bj][n * 4 + 3]} * rf;
#pragma unroll
                        for (int j = 0; j < 4; ++j) { const h16 h = (h16)((float)xs[m][bj][n * 4 + j] + dv[j]); hv[n * 4 + j] = h; const float f = (float)h; ss += f * f; am = fmaxf(am, fabsf(f)); } }
                    *(h16x8*)(dst + o + bj * 128) = hv; }
                ss = xor_add(ss, lane, 16); ss = xor_add(ss, lane, 32);
                am = fmaxf(am, __builtin_bit_cast(float, __builtin_amdgcn_ds_bpermute((lane ^ 16) << 2, __builtin_bit_cast(int, am))));
                am = fmaxf(am, __builtin_bit_cast(float, __builtin_amdgcn_ds_bpermute((lane ^ 32) << 2, __builtin_bit_cast(int, am))));
                if (fq == 0) { u32x2 pr; pr.x = __float_as_uint(ss); pr.y = __float_as_uint(am); *(u32x2*)(SSQ1 + ((size_t)row * 16 + u.pn * 4 + wc) * 2) = pr; } } }
    }
};
__device__ __forceinline__ void ssm_tables(const float* const* in, int l, int g, int p, h16* BSt, h16* MYt, float* AT, LAS float* tbl, int tid) {
    LAS float* PW = tbl;
    LAS float* BB = tbl + 4224;
    LAS float* CC = tbl + 6272;
    LAS float* KT = tbl + 6528;
    const float dt = expf(in[9][l * NG + g]);
    __syncthreads();
    if (tid < NS) { const int n = tid; const float lr = in[7][(l * NG + g) * NS + n], li = in[8][(l * NG + g) * NS + n];
        const float mag = expf(lr * dt), are = mag * __cosf(li * dt), aim = mag * __sinf(li * dt); float pr = 1.f, pi = 0.f; asm volatile("" : "+v"(pr), "+v"(pi));
        for (int d = 0; d <= TCH; ++d) { PW[(n * 33 + d) * 2] = pr; PW[(n * 33 + d) * 2 + 1] = pi; const float nr = pr * are - pi * aim, ni = pr * aim + pi * are; pr = nr; pi = ni; } }
    for (int idx = tid; idx < NS * SGC; idx += NTHREADS) { const int n = idx >> 4, cc = idx & 15; const float lr = in[7][(l * NG + g) * NS + n], li = in[8][(l * NG + g) * NS + n];
        const float x = lr * dt, y = li * dt, cy = __cosf(y), sy = __sinf(y), sh = __sinf(0.5f * y), nr = expm1f(x) * cy - 2.f * sh * sh, aim = expf(x) * sy, den = lr * lr + li * li;
        const float qre = (nr * lr + aim * li) / den, qim = (aim * lr - nr * li) / den;
        const float br = in[10][((size_t)(l * NG + g) * NS + n) * SGC + cc], bi = in[11][((size_t)(l * NG + g) * NS + n) * SGC + cc];
        BB[idx * 2] = qre * br - qim * bi; BB[idx * 2 + 1] = qre * bi + qim * br; }
    for (int idx = tid; idx < 2 * NS; idx += NTHREADS) { const int cl = idx >> 6, n = idx & 63, co = 2 * p + cl;
        CC[idx * 2] = in[12][((size_t)(l * NG + g) * SGC + co) * NS + n]; CC[idx * 2 + 1] = in[13][((size_t)(l * NG + g) * SGC + co) * NS + n]; }
    __syncthreads();
    for (int idx = tid; idx < 32 * 2 * 16; idx += NTHREADS) { const int d = idx >> 5, cl = (idx >> 4) & 1, ci = idx & 15; float s = 0.f;
        for (int n = 0; n < NS; ++n) { const float cr = CC[(cl * 64 + n) * 2], cim = CC[(cl * 64 + n) * 2 + 1], pr = PW[(n * 33 + d) * 2], pi = PW[(n * 33 + d) * 2 + 1], br = BB[(n * 16 + ci) * 2], bi = BB[(n * 16 + ci) * 2 + 1];
            const float xr = cr * pr - cim * pi, xi = cr * pi + cim * pr; s += xr * br - xi * bi; }
        KT[idx] = s; }
    __syncthreads();
    for (int idx = tid; idx < 64 * 80; idx += NTHREADS) { const int rl = idx / 80, q = idx % 80, t = rl >> 1, cl = rl & 1, co = 2 * p + cl; float o[8];
        if (q < 64) { const int s = q >> 1, ci0 = (q & 1) * 8;
#pragma unroll
            for (int j = 0; j < 8; ++j) o[j] = (s <= t) ? KT[((t - s) * 2 + cl) * 16 + ci0 + j] * SSM_SCALE : 0.f; }
        else { const int im = (q >= 72), n0 = (q - 64 - 8 * im) * 8;
#pragma unroll
            for (int j = 0; j < 8; ++j) { const int n = n0 + j; const float cr = CC[(cl * 64 + n) * 2], cim = CC[(cl * 64 + n) * 2 + 1], pr = PW[(n * 33 + t + 1) * 2], pi = PW[(n * 33 + t + 1) * 2 + 1];
                o[j] = (im ? -(cr * pi + cim * pr) : (cr * pr - cim * pi)) * SSM_SCALE; } }
        u32x4 w; w.x = pk_h16(o[0], o[1]); w.y = pk_h16(o[2], o[3]); w.z = pk_h16(o[4], o[5]); w.w = pk_h16(o[6], o[7]);
        *(u32x4*)(MYt + ((size_t)g * 512 + t * 16 + co) * 640 + q * 8) = w; }
    for (int idx = tid; idx < 32 * 64; idx += NTHREADS) { const int rl = idx >> 6, q = idx & 63, s = q >> 1, c0 = (q & 1) * 8; float o[8]; int row;
        if (rl < 16) { const int im = rl >> 3, n = 8 * p + (rl & 7); row = im * 64 + n; const float pr = PW[(n * 33 + (TCH - 1 - s)) * 2], pi = PW[(n * 33 + (TCH - 1 - s)) * 2 + 1];
#pragma unroll
            for (int j = 0; j < 8; ++j) { const float br = BB[(n * 16 + c0 + j) * 2], bi = BB[(n * 16 + c0 + j) * 2 + 1]; o[j] = (im ? (pr * bi + pi * br) : (pr * br - pi * bi)) * SSM_SCALE; } }
        else { row = 128 + 16 * p + (rl - 16);
#pragma unroll
            for (int j = 0; j < 8; ++j) o[j] = 0.f; }
        u32x4 w; w.x = pk_h16(o[0], o[1]); w.y = pk_h16(o[2], o[3]); w.z = pk_h16(o[4], o[5]); w.w = pk_h16(o[6], o[7]);
        *(u32x4*)(BSt + ((size_t)g * 256 + row) * 512 + q * 8) = w; }
    if (p == 0 && tid < NS) { AT[(g * NS + tid) * 2] = PW[(tid * 33 + TCH) * 2]; AT[(g * NS + tid) * 2 + 1] = PW[(tid * 33 + TCH) * 2 + 1]; }
    __syncthreads();
}

struct Args { const float* in[28]; float* out; unsigned char* ws; int ph_lo, ph_hi; };

constexpr int PPL = 12;
constexpr int NPH = DEPTH * PPL;

struct Ctx { const float* const* in; float* out; GAS unsigned char* ws; LAS unsigned char* lds; int l, G, bid, probe, wv; };
#define OPQ() int tid = c.wv * 64 + lane_id_(); asm volatile("" : "+v"(tid)); const int lane = tid & 63, wave = __builtin_amdgcn_readfirstlane(tid >> 6); (void)lane; (void)wave
#define WSP(T, off) ((T*)(GAS T*)(c.ws + (off)))

__device__ __forceinline__ void ph_norm_in(const Ctx& c) {
    OPQ(); h16* X16 = WSP(h16, WS_HH); float* RR0 = WSP(float, WS_RR0); const float* xsrc = c.in[0]; unsigned* X8 = WSP(unsigned, WS_X8);
    for (int row = c.bid * NWAVES + wave; row < NTOK; row += c.G * NWAVES) {
        const f32x4* xr = (const f32x4*)(xsrc + (size_t)row * DM) + lane; float s = 0.f, am = 0.f; u32x2* hr = (u32x2*)(X16 + (size_t)row * DM) + lane; f32x4 fv[4];
#pragma unroll
        for (int j = 0; j < 4; ++j) { const f32x4 v = __builtin_nontemporal_load(xr + 64 * j); h16x4 h;
#pragma unroll
            for (int e = 0; e < 4; ++e) { h[e] = (h16)v[e]; const float f = (float)h[e]; fv[j][e] = f; s += f * f; am = fmaxf(am, fabsf(f)); }
            hr[64 * j] = __builtin_bit_cast(u32x2, h); }
        const float r = 1.0f / sqrtf(wave_sum(s, lane) * (1.0f / DM) + eps_());
        am = wave_max(am, lane); const float inv = am > 1e-30f ? 127.0f / am : 0.f;
#pragma unroll
        for (int j = 0; j < 4; ++j) X8[(size_t)row * (DM / 4) + lane + 64 * j] = pk_i8(fv[j][0], fv[j][1], fv[j][2], fv[j][3], inv);
        if (lane == 0) RR0[row] = r * am * (1.0f / (127.0f * 127.0f));
    }
}
__device__ __forceinline__ void ph_tables(const Ctx& c) {
    OPQ();
    for (int it = c.bid; it < NG * 8; it += c.G) ssm_tables(c.in, c.l, it >> 3, it & 7, WSP(h16, WS_BS), WSP(h16, WS_MY), WSP(float, WS_AT), (LAS float*)c.lds, tid);
    { const int l = c.l; h16* WRf = WSP(h16, WS_WR); const float* gf = c.in[19] + l * DM; const float* wrg = c.in[20] + (size_t)l * DM * MG; const float* wre = c.in[22] + (size_t)l * DM * NE;
      for (int idx = c.bid * NTHREADS + tid; idx < 32 * 3 * 2 * 64; idx += c.G * NTHREADS) { const int ln = idx & 63, hl = (idx >> 6) & 1, nb = (idx >> 7) % 3, kk = (idx >> 7) / 3, n = nb * 16 + (ln & 15); float o[8];
#pragma unroll
          for (int j = 0; j < 8; ++j) { const int k = (kk >> 2) * 128 + (ln >> 4) * 32 + (kk & 3) * 8 + j;     float w = n < MG ? wrg[(size_t)k * MG + n] : (n < MG + NE ? wre[(size_t)k * NE + n - MG] : 0.f); w *= gf[k];
              const float hi = (float)(h16)w; o[j] = hl ? (w - hi) : hi; }
          u32x4 wv; wv.x = pk_h16(o[0], o[1]); wv.y = pk_h16(o[2], o[3]); wv.z = pk_h16(o[4], o[5]); wv.w = pk_h16(o[6], o[7]);
          *(u32x4*)(WRf + (size_t)idx * 8) = wv; } }
}
constexpr int I_D = (DE / 64) * (DM / 64), NITE = NE * I_D;
constexpr int NSTRIP = NE * 2 * (DE / 64);
#define WGU_SET(l) ((l) & 1 ? WSP(h16, WS_W2) : WSP(h16, WS_WGU))
#define WGU8_SET(l) ((l) & 1 ? WSP(unsigned char, WS_WGU) : WSP(unsigned char, WS_WGU8))
#define WD_SET(l)  ((l) & 1 ? WSP(h16, WS_W2 + 64 * MiB) : WSP(h16, WS_WD))
__device__ __forceinline__ void expert_item(const Ctx& c, int lw, int it, LAS float* scr, int lane) {
    h16* WdT = WD_SET(lw);
    const int e = it / I_D, r = it - e * I_D, kb = r / (DM / 64), nb = r % (DM / 64);
    transpose_item(c.in[26] + ((size_t)lw * NE + e) * DE * DM, DM, WdT + (size_t)e * 1024 * 512, DE, nullptr, scr, kb * 64, nb * 64, nb * 64, lane);
}
__device__ __forceinline__ void wstrips(const Ctx& c, const int l, const int first, const int step) {
    OPQ(); unsigned char* W8 = WGU8_SET(l); float* WME = WSP(float, WS_WME) + (size_t)l * NE * 1024; const float* ks = c.in[19] + l * DM;
    LAS unsigned char* T = c.lds + wave * 8192; LAS float* mx = (LAS float*)(c.lds + 65536);
    const int nq = lane & 15, kr = lane >> 4;
    for (int it = first; it < NSTRIP; it += step) {
        const int e = it >> 4, up = (it >> 3) & 1, n0 = (it & 7) * 64, drow0 = 256 * (n0 >> 7) + 128 * up + (n0 & 127);
        const int k0 = wave * 128 + kr * 32;
        const float* W = (up ? c.in[25] : c.in[24]) + ((size_t)l * NE + e) * DM * DE + n0 + 4 * nq + (size_t)k0 * DE; asm volatile("" : "+v"(W));
        f32x4 v[32];
#pragma unroll
        for (int i = 0; i < 32; ++i) v[i] = __builtin_nontemporal_load((const f32x4*)(W + (size_t)i * DE));
        f32x4 m = {0.f, 0.f, 0.f, 0.f};
#pragma unroll
        for (int i = 0; i < 32; ++i) { v[i] = v[i] * ks[k0 + i];
#pragma unroll
            for (int e4 = 0; e4 < 4; ++e4) m[e4] = fmaxf(m[e4], fabsf(v[i][e4])); }
#pragma unroll
        for (int e4 = 0; e4 < 4; ++e4) { float x = m[e4];
            x = fmaxf(x, __builtin_bit_cast(float, __builtin_amdgcn_ds_bpermute((lane ^ 16) << 2, __builtin_bit_cast(int, x))));
            x = fmaxf(x, __builtin_bit_cast(float, __builtin_amdgcn_ds_bpermute((lane ^ 32) << 2, __builtin_bit_cast(int, x)))); m[e4] = x; }
        __syncthreads();
        if (kr == 0) *(LAS f32x4*)(mx + wave * 64 + 4 * nq) = m;
        __syncthreads();
        f32x4 cm = *(const LAS f32x4*)(mx + 4 * nq);
#pragma unroll
        for (int w = 1; w < NWAVES; ++w) { const f32x4 o = *(const LAS f32x4*)(mx + w * 64 + 4 * nq);
#pragma unroll
            for (int e4 = 0; e4 < 4; ++e4) cm[e4] = fmaxf(cm[e4], o[e4]); }
        if (wave == 0 && kr == 0) *(f32x4*)(WME + (size_t)e * 1024 + drow0 + 4 * nq) = cm;
#pragma unroll
        for (int e4 = 0; e4 < 4; ++e4) { const float inv = cm[e4] > 1e-30f ? 127.0f / cm[e4] : 0.f; u32x4 w0, w1;
            w0.x = pk_i8(v[0][e4], v[1][e4], v[2][e4], v[3][e4], inv); w0.y = pk_i8(v[4][e4], v[5][e4], v[6][e4], v[7][e4], inv); w0.z = pk_i8(v[8][e4], v[9][e4], v[10][e4], v[11][e4], inv); w0.w = pk_i8(v[12][e4], v[13][e4], v[14][e4], v[15][e4], inv);
            w1.x = pk_i8(v[16][e4], v[17][e4], v[18][e4], v[19][e4], inv); w1.y = pk_i8(v[20][e4], v[21][e4], v[22][e4], v[23][e4], inv); w1.z = pk_i8(v[24][e4], v[25][e4], v[26][e4], v[27][e4], inv); w1.w = pk_i8(v[28][e4], v[29][e4], v[30][e4], v[31][e4], inv);
            LAS u32x4* tp = (LAS u32x4*)(T + (4 * nq + e4) * 128 + kr * 32); tp[0] = w0; tp[1] = w1; }
        asm volatile("s_waitcnt lgkmcnt(0)" ::: "memory");
#pragma unroll
        for (int j = 0; j < 8; ++j) { const int id = lane + 64 * j, n = id >> 3, ch = id & 7; const u32x4 o = *(const LAS u32x4*)(T + n * 128 + ch * 16);
            __builtin_nontemporal_store(o, (u32x4*)(W8 + ((size_t)e * 1024 + drow0 + n) * DM + wave * 128 + ch * 16)); }
        asm volatile("s_waitcnt lgkmcnt(0)" ::: "memory");
    }
    __syncthreads();
}
__device__ __forceinline__ void hs_load(const Ctx& c, int l, int it, int tid, f32x4 (&v)[16]) {
    const int wave = tid >> 6, lane = tid & 63, nq = lane & 7, kr = lane >> 3, e = it >> 5, up = (it >> 4) & 1, n0 = (it & 15) * 32, k0 = wave * 128 + kr * 16;
    const float* W = (up ? c.in[25] : c.in[24]) + ((size_t)l * NE + e) * DM * DE + n0 + 4 * nq + (size_t)k0 * DE; asm volatile("" : "+v"(W));
#pragma unroll
    for (int i = 0; i < 16; ++i) v[i] = __builtin_nontemporal_load((const f32x4*)(W + (size_t)i * DE));
}
__device__ __forceinline__ void hs_process(const Ctx& c, int l, int it, int tid, f32x4 (&v)[16]) {
    const int wave = tid >> 6, lane = tid & 63, nq = lane & 7, kr = lane >> 3, e = it >> 5, up = (it >> 4) & 1, n0 = (it & 15) * 32, k0 = wave * 128 + kr * 16, drow0 = 256 * (n0 >> 7) + 128 * up + (n0 & 127);
    unsigned char* W8 = WGU8_SET(l); float* WME = WSP(float, WS_WME) + (size_t)l * NE * 1024; const float* ks = c.in[19] + l * DM;
    LAS unsigned char* T = c.lds + wave * 4096; LAS float* mx = (LAS float*)(c.lds + 32768);
    f32x4 m = {0.f, 0.f, 0.f, 0.f};
#pragma unroll
    for (int i = 0; i < 16; ++i) { v[i] = v[i] * ks[k0 + i];
#pragma unroll
        for (int e4 = 0; e4 < 4; ++e4) m[e4] = fmaxf(m[e4], fabsf(v[i][e4])); }
#pragma unroll
    for (int e4 = 0; e4 < 4; ++e4) { float x = m[e4];
        x = fmaxf(x, __builtin_bit_cast(float, __builtin_amdgcn_ds_bpermute((lane ^ 8) << 2, __builtin_bit_cast(int, x))));
        x = fmaxf(x, __builtin_bit_cast(float, __builtin_amdgcn_ds_bpermute((lane ^ 16) << 2, __builtin_bit_cast(int, x))));
        x = fmaxf(x, __builtin_bit_cast(float, __builtin_amdgcn_ds_bpermute((lane ^ 32) << 2, __builtin_bit_cast(int, x)))); m[e4] = x; }
    __syncthreads();
    if (kr == 0) *(LAS f32x4*)(mx + wave * 32 + 4 * nq) = m;
    __syncthreads();
    f32x4 cm = *(const LAS f32x4*)(mx + 4 * nq);
#pragma unroll
    for (int w = 1; w < NWAVES; ++w) { const f32x4 o = *(const LAS f32x4*)(mx + w * 32 + 4 * nq);
#pragma unroll
        for (int e4 = 0; e4 < 4; ++e4) cm[e4] = fmaxf(cm[e4], o[e4]); }
    if (wave == 0 && kr == 0) *(f32x4*)(WME + (size_t)e * 1024 + drow0 + 4 * nq) = cm;
#pragma unroll
    for (int e4 = 0; e4 < 4; ++e4) { const float inv = cm[e4] > 1e-30f ? 127.0f / cm[e4] : 0.f; u32x4 w0;
        w0.x = pk_i8(v[0][e4], v[1][e4], v[2][e4], v[3][e4], inv); w0.y = pk_i8(v[4][e4], v[5][e4], v[6][e4], v[7][e4], inv); w0.z = pk_i8(v[8][e4], v[9][e4], v[10][e4], v[11][e4], inv); w0.w = pk_i8(v[12][e4], v[13][e4], v[14][e4], v[15][e4], inv);
        *(LAS u32x4*)(T + (4 * nq + e4) * 128 + kr * 16) = w0; }
    asm volatile("s_waitcnt lgkmcnt(0)" ::: "memory");
#pragma unroll
    for (int j = 0; j < 4; ++j) { const int id = lane + 64 * j, n = id >> 3, ch = id & 7; const u32x4 o = *(const LAS u32x4*)(T + n * 128 + ch * 16);
        __builtin_nontemporal_store(o, (u32x4*)(W8 + ((size_t)e * 1024 + drow0 + n) * DM + wave * 128 + ch * 16)); }
    asm volatile("s_waitcnt lgkmcnt(0)" ::: "memory");
}
__device__ __forceinline__ void wstrips_piped(const Ctx& c, const int l, const int first, const int step) {
    OPQ(); f32x4 va[16], vb[16];
    int it = first; if (it < 2 * NSTRIP) hs_load(c, l, it, tid, va);
    while (it < 2 * NSTRIP) {
        const int i1 = it + step, i2 = i1 + step;
        if (i1 < 2 * NSTRIP) hs_load(c, l, i1, tid, vb);
        hs_process(c, l, it, tid, va);
        if (i1 >= 2 * NSTRIP) break;
        if (i2 < 2 * NSTRIP) hs_load(c, l, i2, tid, va);
        hs_process(c, l, i1, tid, vb);
        it = i2;
    }
    __syncthreads();
}
__device__ __forceinline__ void ph_wstrips(const Ctx& c) { wstrips(c, c.l, c.bid, c.G); }
constexpr int NCONV = 64; constexpr bool BG_CONVERT = false;
#define MOE_G(c) ((c).l + 1 < DEPTH ? (c).G - NCONV : (c).G)
__device__ __forceinline__ void ph_convert(const Ctx& c) {
    const int Gm = MOE_G(c); if (c.bid < Gm) return;
    OPQ(); const int l1 = c.l + 1, cb = c.bid - Gm, nc = c.G - Gm;
    LAS float* scr = (LAS float*)(c.lds + wave * 17408);
    for (int it = cb * NWAVES + wave; it < NITE; it += nc * NWAVES) expert_item(c, l1, it, scr, lane);
    __syncthreads();
    wstrips(c, l1, cb, nc);
}
__device__ __forceinline__ void ph_wmax(const Ctx& c) {
    OPQ(); constexpr int I_IN = (DM / 64) * (INW / 64);
    const int gw = c.bid * NWAVES + wave, NGW = c.G * NWAVES;
    constexpr int I_OUT = (DM / 64) * (DM / 64);
    for (int it = gw; it < DEPTH * (I_IN + I_OUT); it += NGW) { const int l = it / (I_IN + I_OUT); int r = it % (I_IN + I_OUT);
        if (r < I_IN) { const int kb = r / (INW / 64), nb = r % (INW / 64), n0 = nb * 64;
            const int dr = n0 < CW ? 256 * (n0 >> 7) + (n0 & 127) : (n0 < 2 * CW ? 256 * ((n0 - CW) >> 7) + 128 + ((n0 - CW) & 127) : n0);
            absmax_item(c.in[2] + (size_t)l * DM * INW, INW, c.in[1] + l * DM, WSP(float, WS_WMAX) + l * INW, kb * 64, n0, dr, lane); }
        else { r -= I_IN; const int kb = r / (DM / 64), nb = r % (DM / 64); absmax_item(c.in[18] + (size_t)l * DM * DM, DM, c.in[17] + l * DM, WSP(float, WS_WMAXO) + l * DM, kb * 64, nb * 64, nb * 64, lane); } }
}
__device__ __forceinline__ void ph_weights(const Ctx& c) {
    OPQ(); const int l = c.l;
    h16* WinT = WSP(h16, WS_WIN); h16* GluT = WSP(h16, WS_GLU); h16* WoutT = WSP(h16, WS_WOUT);
    LAS float* scr = (LAS float*)(c.lds + wave * 17408);
    const int gw = c.bid * NWAVES + wave, NGW = c.G * NWAVES;
    constexpr int I_IN = (DM / 64) * (INW / 64), I_GLU = (SW / 64) * (SW / 64), I_OUT = (DM / 64) * (DM / 64);
    const int NIT = I_IN + I_GLU + I_OUT + (l == 0 ? NITE : 0);
    for (int it = gw; it < NIT; it += NGW) { int r = it;
        if (r < I_IN) { const int kb = r / (INW / 64), nb = r % (INW / 64), n0 = nb * 64;
            const int dr = n0 < CW ? 256 * (n0 >> 7) + (n0 & 127) : (n0 < 2 * CW ? 256 * ((n0 - CW) >> 7) + 128 + ((n0 - CW) & 127) : n0);
            transpose_item_q8(c.in[2] + (size_t)l * DM * INW, INW, (unsigned char*)WinT, DM, c.in[1] + l * DM, WSP(const float, WS_WMAX) + l * INW, scr, kb * 64, n0, dr, lane); continue; } r -= I_IN;
        if (r < I_GLU) { const int kb = r / (SW / 64), nb = r % (SW / 64); transpose_item(c.in[15] + (size_t)l * SW * SW, SW, GluT, SW, nullptr, scr, kb * 64, nb * 64, nb * 64, lane); continue; } r -= I_GLU;
        if (r < I_OUT) { const int kb = r / (DM / 64), nb = r % (DM / 64); transpose_item_q8(c.in[18] + (size_t)l * DM * DM, DM, (unsigned char*)WoutT, DM, c.in[17] + l * DM, WSP(const float, WS_WMAXO) + l * DM, scr, kb * 64, nb * 64, nb * 64, lane, true); continue; } r -= I_OUT;
        expert_item(c, 0, r, scr, lane);
    }
}
__device__ __forceinline__ void bg_finish(const Ctx& c, int lw, int& done) {
    if (lw < 1 || lw >= DEPTH) return;
    OPQ(); LAS float* scr = (LAS float*)(c.lds + wave * 17408); const int gw = c.bid * NWAVES + wave, NGW = c.G * NWAVES;
    for (; gw + done * NGW < NITE; ++done) expert_item(c, lw, gw + done * NGW, scr, lane);
}
__device__ __forceinline__ void ph_gemm_in(const Ctx& c) {
    eng::DenseOrder S; S.init(NTOK, INW, c.G, c.bid, DM, DM);
    eng::gemm_phase(c.lds, eng::Geo{DM, 128, 128, DM / 128}, WSP(h16, WS_X8), WSP(h16, WS_WIN), S, EpiIn{WSP(h16, WS_U), WSP(h16, WS_SG), WSP(const float, WS_RR0), WSP(const float, WS_WMAX) + c.l * INW}, c.wv);
}
__device__ __forceinline__ void ph_ssm_s(const Ctx& c) {
    SsmSOrder S; S.G = c.G; S.c = c.bid;
    eng::gemm_phase(c.lds, eng::Geo{1024, 128, 128, 8}, WSP(h16, WS_SG), WSP(h16, WS_BS), S, EpiS{WSP(h16, WS_SG), WSP(const float, WS_AT)}, c.wv);
    if (SsmSOrder::unit_of(c.G, c.bid) >= 0) {
        if (c.wv == 0) { __builtin_amdgcn_fence(__ATOMIC_ACQUIRE, "agent"); asm volatile("s_waitcnt vmcnt(0)" ::: "memory"); }
        __syncthreads();
        SsmYLocal Y; Y.G = c.G; Y.c = c.bid;
        eng::gemm_phase(c.lds, eng::Geo{1280, 128, 128, 10}, WSP(h16, WS_SG), WSP(h16, WS_MY), Y, EpiY{WSP(const h16, WS_SG), c.in[14] + c.l * SW, WSP(h16, WS_VH)}, c.wv);
    }
}
__device__ __forceinline__ void ph_ssm_y(const Ctx& c) {
    SsmYOrder S; S.G = c.G; S.c = c.bid;
    eng::gemm_phase(c.lds, eng::Geo{1280, 128, 128, 10}, WSP(h16, WS_SG), WSP(h16, WS_MY), S, EpiY{WSP(const h16, WS_SG), c.in[14] + c.l * SW, WSP(h16, WS_VH)}, c.wv);
}
__device__ __forceinline__ void ph_gemm_glu(const Ctx& c) {
    GluOrder S; S.init(NTOK, SW, c.G, c.bid, 32, SW * 2);
    eng::gemm_phase(c.lds, eng::Geo{SW * 2, 4u * NTOK * 32u, 128, SW / 64}, WSP(h16, WS_VH), WSP(h16, WS_GLU), S, EpiGlu{WSP(const h16, WS_VH), c.in[16] + c.l * SW, WSP(unsigned char, WS_YH), WSP(float, WS_SSQ2), WSP(float, WS_SIGS), c.lds}, c.wv);
}
__device__ __forceinline__ void ph_conv(const Ctx& c) {
    OPQ(); const int l = c.l;
    const h16* U = WSP(const h16, WS_U); unsigned char* YH8 = WSP(unsigned char, WS_YH); float* SIGC = WSP(float, WS_SIGC);
    LAS h16* Ut = (LAS h16*)c.lds; LAS h16* Ot = (LAS h16*)(c.lds + 94 * 1024);
    const int cp = tid & 255, th = tid >> 8;
    const float* cw = c.in[3] + (size_t)l * CKW * CW + 2 * cp;
    h16x2 wp[CKW];
#pragma unroll
    for (int j = 0; j < CKW; ++j) wp[j] = (h16x2){(h16)cw[j * CW], (h16)cw[j * CW + 1]};
    const h16x2 bp = {(h16)c.in[4][l * CW + 2 * cp], (h16)c.in[4][l * CW + 2 * cp + 1]};
    float lg[8], lb[8];
#pragma unroll
    for (int j = 0; j < 8; ++j) { lg[j] = c.in[5][l * CW + lane * 8 + j]; lb[j] = c.in[6][l * CW + lane * 8 + j]; }
    unsigned* cq = WSP(unsigned, WS_CQ) + l * 64; volatile LAS unsigned* slot = (volatile LAS unsigned*)(c.lds + LDS_BYTES - 128);
    __syncthreads();
    if (tid == 0) { slot[0] = atomicAdd(cq, 1u); slot[1] = atomicAdd(cq, 1u); }
    __syncthreads();
    int unit = (int)slot[0], nunit = (int)slot[1];
    u32x4 sv[12];
#define CONV_LOAD(un) do { const int b_ = (un) >> 5, t0_ = ((un) & 31) * 64; _Pragma("unroll") for (int it = 0; it < 12; ++it) { const int q = tid + it * NTHREADS, r = q >> 6, ch = q & 63, t = t0_ - (CKW - 1) + r; \
        sv[it] = (u32x4){0u, 0u, 0u, 0u}; if (q < 94 * 64 && t >= 0) sv[it] = *(const u32x4*)(U + ((size_t)b_ * SEQ + t) * CW + ch * 8); } } while (0)
    if (unit < NTOK / 64) CONV_LOAD(unit);
    for (;;) {
        if (unit >= NTOK / 64) break;
        const int b = unit >> 5, t0 = (unit & 31) * 64; const size_t tokb = (size_t)b * SEQ;
#pragma unroll
        for (int it = 0; it < 12; ++it) { const int q = tid + it * NTHREADS, r = q >> 6, ch = q & 63; if (q < 94 * 64) *(LAS u32x4*)(Ut + r * 512 + ch * 8) = sv[it]; }
        __syncthreads();
        if (nunit < NTOK / 64) CONV_LOAD(nunit);
        unsigned claim = 0u; if (tid == 0) claim = atomicAdd(cq, 1u);
#pragma unroll 1
        for (int half = 0; half < 2; ++half) {
            { const int i0 = half * 32 + th * 16;
                h16x2 a[16];
#pragma unroll
                for (int k = 0; k < 16; ++k) a[k] = bp;
#pragma unroll
                for (int r = 0; r < 46; ++r) { const h16x2 hv = *(const LAS h16x2*)(Ut + (i0 + r) * 512 + 2 * cp);
#pragma unroll
                    for (int k = 0; k < 16; ++k) { const int j = r - k; if (j >= 0 && j < CKW) a[k] = wp[j] * hv + a[k]; } }
#pragma unroll
                for (int k = 0; k < 16; ++k) *(LAS h16x2*)(Ot + (th * 16 + k) * 512 + 2 * cp) = a[k];
            }
            __syncthreads();
            {
                float v[4][8], s1[4], s2[4];
#pragma unroll
                for (int q = 0; q < 4; ++q) { const int lt = wave * 4 + q; const size_t tok = tokb + t0 + half * 32 + lt;
                    const h16x8 hv = *(const LAS h16x8*)(Ot + lt * 512 + lane * 8); s1[q] = 0.f; s2[q] = 0.f;
#pragma unroll
                    for (int j = 0; j < 8; ++j) { v[q][j] = (float)hv[j]; s1[q] += v[q][j]; s2[q] += v[q][j] * v[q][j]; } }
#pragma unroll
                for (int o = 1; o < 64; o <<= 1) {
#pragma unroll
                    for (int q = 0; q < 4; ++q) { s1[q] = xor_add(s1[q], lane, o); s2[q] = xor_add(s2[q], lane, o); } }
                float s3[4], vm[4];
#pragma unroll
                for (int q = 0; q < 4; ++q) { vm[q] = 0.f; const float mean = s1[q] * (1.0f / CW), var = fmaxf(s2[q] * (1.0f / CW) - mean * mean, 0.f), rstd = 1.0f / sqrtf(var + eps_()); s3[q] = 0.f;
#pragma unroll
                    for (int j = 0; j < 8; ++j) { float y = (v[q][j] - mean) * rstd * lg[j] + lb[j]; y = y * fsigmoid(y); v[q][j] = y; s3[q] += y * y; vm[q] = fmaxf(vm[q], fabsf(y)); } }
#pragma unroll
                for (int o = 1; o < 64; o <<= 1) {
#pragma unroll
                    for (int q = 0; q < 4; ++q) { s3[q] = xor_add(s3[q], lane, o); vm[q] = fmaxf(vm[q], __builtin_bit_cast(float, __builtin_amdgcn_ds_bpermute((lane ^ o) << 2, __builtin_bit_cast(int, vm[q])))); } }
#pragma unroll
                for (int q = 0; q < 4; ++q) { const int lt = wave * 4 + q; const size_t tok = tokb + t0 + half * 32 + lt;
                    const float sc = 1.0f / sqrtf(s3[q] * (1.0f / CW) + eps_()), inv = vm[q] > 1e-30f ? 127.0f / vm[q] : 0.f;
                    u32x2 w; w.x = pk_i8(v[q][0], v[q][1], v[q][2], v[q][3], inv); w.y = pk_i8(v[q][4], v[q][5], v[q][6], v[q][7], inv);
                    *(u32x2*)(YH8 + tok * DM + lane * 8) = w; if (lane == 0) SIGC[tok] = sc * vm[q] * (1.0f / 127.0f); }
            }
            if (half == 1 && tid == 0) slot[0] = claim;
            __syncthreads();
        }
        unit = nunit; nunit = (int)slot[0];
    }
#undef CONV_LOAD
}
__device__ __forceinline__ void ph_gemm_out(const Ctx& c) {
    OPQ(); eng::DenseOrder S; S.init(NTOK, DM, c.G, c.bid, DM, DM);
    { LAS float* fac = (LAS float*)(c.lds + 131584); eng::Unit u; const int ui = tid >> 8, r = tid & 255;
      __syncthreads();
      if (S.next(ui, u)) { const int tok = u.pm * 256 + r; const f32x4 q0 = *(const f32x4*)(WSP(const float, WS_SSQ2) + (size_t)tok * 8), q1 = *(const f32x4*)(WSP(const float, WS_SSQ2) + (size_t)tok * 8 + 4);
          const float r2 = 1.0f / sqrtf(((q0[0] + q0[1]) + (q0[2] + q0[3]) + (q1[0] + q1[1]) + (q1[2] + q1[3])) * (1.0f / SW) + eps_());
          const float s0 = WSP(const float, WS_SIGS)[(size_t)tok * 2], s1 = WSP(const float, WS_SIGS)[(size_t)tok * 2 + 1], sc = WSP(const float, WS_SIGC)[tok];
          const float e0 = s0, e1 = s1 > 0.f ? s1 : e0, rho1 = e1 > 0.f ? fminf(e0 / e1, 256.0f) : 1.0f, p1 = e1 * r2, ec = sc > 0.f ? sc : p1, rho2 = ec > 0.f ? fminf(p1 / ec, 256.0f) : 1.0f;
          *(LAS f32x4*)(fac + (size_t)(ui * 256 + r) * 4) = (f32x4){rho1, rho2, ec * (1.0f / 127.0f), 0.f}; }
      __syncthreads(); }
    eng::gemm_phase(c.lds, eng::Geo{DM, 128, 128, DM / 128, 4, 2, 4}, WSP(h16, WS_YH), WSP(h16, WS_WOUT), S, EpiOut{WSP(const h16, WS_HH), c.probe ? WSP(h16, WS_R1) : WSP(h16, WS_HH), WSP(float, WS_SQA), WSP(const float, WS_WMAXO) + c.l * DM, c.lds}, c.wv);
}
__device__ __forceinline__ void ph_router(const Ctx& c) {
    OPQ(); const int l = c.l;
    const h16* X16 = WSP(const h16, WS_HH); u32x4* recs = c.probe ? WSP(u32x4, WS_R1) : WSP(u32x4, WS_LIST); unsigned* cnt = WSP(unsigned, WS_CNT) + l * 2048 + (c.probe ? 32 : 0);
    const float* SQA = WSP(const float, WS_SQA); const h16x8* WRf = WSP(const h16x8, WS_WR); unsigned char* X8B = WSP(unsigned char, WS_X8B);
    LAS float* invl = (LAS float*)(c.lds + 122880);
    const float* brg = c.in[21] + l * MG; const float* bre = c.in[23] + l * NE;
    LAS float* Ps = (LAS float*)(c.lds + wave * 12288);
    LAS float* Lg = (LAS float*)(c.lds + 98304);
    LAS unsigned* cntl = (LAS unsigned*)(c.lds + 131072);
    const int r = lane & 15, q = lane >> 4;
    h16x8 wf[4][3][2];
#pragma unroll
    for (int u = 0; u < 4; ++u)
#pragma unroll
        for (int nb = 0; nb < 3; ++nb) { wf[u][nb][0] = WRf[(((wave * 4 + u) * 3 + nb) * 2 + 0) * 64 + lane]; wf[u][nb][1] = WRf[(((wave * 4 + u) * 3 + nb) * 2 + 1) * 64 + lane]; }
    for (int tile = c.bid; tile < NTOK / 128; tile += c.G) {
        __syncthreads();
        if (tid < 64) cntl[tid] = 0u;
        const int tok0 = tile * 128;
        float rt = 0.f, amx = 0.f;
        if (tid < 128) { const f32x4* sq = (const f32x4*)(SQA + (size_t)(tok0 + tid) * 32); float ssum = 0.f;
#pragma unroll
            for (int i = 0; i < 8; ++i) { const f32x4 v = sq[i]; ssum += v[0] + v[2]; amx = fmaxf(amx, fmaxf(v[1], v[3])); }
            rt = 1.0f / sqrtf(ssum * (1.0f / DM) + eps_()); invl[tid] = amx > 1e-30f ? 127.0f / amx : 0.f; }
        __syncthreads();
#pragma unroll 1
        for (int hf = 0; hf < 2; ++hf) {
            h16x8 xa[4][4];
#pragma unroll
            for (int t = 0; t < 4; ++t)
#pragma unroll
                for (int u = 0; u < 4; ++u) xa[t][u] = *(const h16x8*)(X16 + (size_t)(tok0 + (hf * 4 + t) * 16 + r) * DM + wave * 128 + q * 32 + u * 8);
#pragma unroll
            for (int t = 0; t < 4; ++t) { const int tl = (hf * 4 + t) * 16 + r; const float inv = invl[tl]; u32x4 w0, w1;
                w0.x = pk_i8((float)xa[t][0][0], (float)xa[t][0][1], (float)xa[t][0][2], (float)xa[t][0][3], inv); w0.y = pk_i8((float)xa[t][0][4], (float)xa[t][0][5], (float)xa[t][0][6], (float)xa[t][0][7], inv);
                w0.z = pk_i8((float)xa[t][1][0], (float)xa[t][1][1], (float)xa[t][1][2], (float)xa[t][1][3], inv); w0.w = pk_i8((float)xa[t][1][4], (float)xa[t][1][5], (float)xa[t][1][6], (float)xa[t][1][7], inv);
                w1.x = pk_i8((float)xa[t][2][0], (float)xa[t][2][1], (float)xa[t][2][2], (float)xa[t][2][3], inv); w1.y = pk_i8((float)xa[t][2][4], (float)xa[t][2][5], (float)xa[t][2][6], (float)xa[t][2][7], inv);
                w1.z = pk_i8((float)xa[t][3][0], (float)xa[t][3][1], (float)xa[t][3][2], (float)xa[t][3][3], inv); w1.w = pk_i8((float)xa[t][3][4], (float)xa[t][3][5], (float)xa[t][3][6], (float)xa[t][3][7], inv);
                u32x4* dp = (u32x4*)(X8B + (size_t)(tok0 + tl) * DM + wave * 128 + q * 32); dp[0] = w0; dp[1] = w1; }
#pragma unroll
            for (int t = 0; t < 4; ++t) { f32x4 acc[3];
#pragma unroll
                for (int nb = 0; nb < 3; ++nb) acc[nb] = (f32x4){0.f, 0.f, 0.f, 0.f};
#pragma unroll
                for (int u = 0; u < 4; ++u)
#pragma unroll
                    for (int nb = 0; nb < 3; ++nb) {
                        acc[nb] = __builtin_amdgcn_mfma_f32_16x16x32_f16(xa[t][u], wf[u][nb][0], acc[nb], 0, 0, 0);
                        acc[nb] = __builtin_amdgcn_mfma_f32_16x16x32_f16(xa[t][u], wf[u][nb][1], acc[nb], 0, 0, 0); }
#pragma unroll
                for (int nb = 0; nb < 3; ++nb)
#pragma unroll
                    for (int rg = 0; rg < 4; ++rg) Ps[(t * 16 + q * 4 + rg) * 48 + nb * 16 + r] = acc[nb][rg]; }
            __syncthreads();
            for (int i = tid; i < 64 * 48; i += NTHREADS) { float s = 0.f;
#pragma unroll
                for (int w = 0; w < NWAVES; ++w) s += ((const LAS float*)(c.lds + w * 12288))[i];
                Lg[hf * 64 * 48 + i] = s; }
            __syncthreads();
        }
        int ea = 0, eb = 0; float g1 = 0.f, g2 = 0.f; unsigned pla = 0u, plb = 0u;
        if (tid < 128) {
            float lg[MG + NE];
#pragma unroll
            for (int o4 = 0; o4 < (MG + NE) / 4; ++o4) { const f32x4 t4 = *(const LAS f32x4*)(Lg + tid * 48 + o4 * 4); lg[o4 * 4] = t4[0] * rt; lg[o4 * 4 + 1] = t4[1] * rt; lg[o4 * 4 + 2] = t4[2] * rt; lg[o4 * 4 + 3] = t4[3] * rt; }
            float gl[MG];
#pragma unroll
            for (int o = 0; o < MG; ++o) gl[o] = lg[o] + brg[o];
            int grp = 0; float gm = gl[0];
#pragma unroll
            for (int o = 1; o < MG; ++o) if (gl[o] > gm) { gm = gl[o]; grp = o; }
            float den = 0.f;
#pragma unroll
            for (int o = 0; o < MG; ++o) den += expf(gl[o] - gm);
            const float pg = 1.0f / den;
            float ev[EPG];
#pragma unroll
            for (int j = 0; j < EPG; ++j) { ev[j] = 0.f;
#pragma unroll
                for (int qq = 0; qq < MG; ++qq) ev[j] = (grp == qq) ? (lg[MG + qq * EPG + j] + bre[qq * EPG + j]) : ev[j]; }
            int i1 = 0; float v1 = ev[0];
#pragma unroll
            for (int j = 1; j < EPG; ++j) if (ev[j] > v1) { v1 = ev[j]; i1 = j; }
            int i2 = -1; float v2 = -3.0e38f;
#pragma unroll
            for (int j = 0; j < EPG; ++j) if (j != i1 && ev[j] > v2) { v2 = ev[j]; i2 = j; }
            const float e2 = expf(v2 - v1); g1 = pg / (1.0f + e2); g2 = pg * e2 / (1.0f + e2);
            ea = grp * EPG + i1; eb = grp * EPG + i2;
            pla = __hip_atomic_fetch_add(cntl + ea, 1u, __ATOMIC_RELAXED, __HIP_MEMORY_SCOPE_WORKGROUP);
            plb = __hip_atomic_fetch_add(cntl + eb, 1u, __ATOMIC_RELAXED, __HIP_MEMORY_SCOPE_WORKGROUP);
        }
        __syncthreads();
        if (tid < NE) cntl[32 + tid] = atomicAdd(&cnt[tid * 64], cntl[tid]);
        __syncthreads();
        if (tid < 128) { const int tok = tok0 + tid; const unsigned rb = __float_as_uint(rt * amx * (1.0f / (127.0f * 127.0f)));
            recs[(size_t)ea * NTOK + cntl[32 + ea] + pla] = (u32x4){(unsigned)(tok * 2), __float_as_uint(g1), rb, 0u};
            recs[(size_t)eb * NTOK + cntl[32 + eb] + plb] = (u32x4){(unsigned)(tok * 2 + 1), __float_as_uint(g2), rb, 0u}; }
    }
}
__device__ __forceinline__ void ph_moe_tb(const Ctx& c) {
    OPQ(); LAS int* tb = (LAS int*)(c.lds + 131072); const unsigned* cnt = WSP(const unsigned, WS_CNT) + c.l * 2048;
    __syncthreads();
    if (tid < NE) tb[40 + tid] = (int)cnt[tid * 64];
    __syncthreads();
    if (tid == 0) { int a = 0; for (int e = 0; e < NE; ++e) { tb[e] = a; a += (tb[40 + e] + 255) / 256; } tb[NE] = a; }
    __syncthreads();
}
__device__ __forceinline__ void ph_moe_gu(const Ctx& c) {
    LAS int* tb = (LAS int*)(c.lds + 131072);
    const int Gm = MOE_G(c);
    MoeGU S; S.tb = tb; S.G = Gm; S.c = c.bid;
    if (Gm < c.G) { S.tlim = 5 * (Gm >> 2); if (c.bid >= Gm) { S.tail0 = S.tlim; S.G = c.G - Gm; S.c = c.bid - Gm; } }
    S.T = __builtin_amdgcn_readfirstlane(tb[NE]); S.list = WSP(const unsigned, WS_LIST);
    eng::gemm_phase(c.lds, eng::Geo{DM, 128, 128, DM / 128}, WSP(h16, WS_X8B), (const h16*)WGU8_SET(c.l), S, EpiHid{WSP(h16, WS_R1), WSP(const unsigned, WS_LIST), tb, WSP(unsigned, WS_TC) + (size_t)c.l * 288 * 64, WSP(const float, WS_WME) + (size_t)c.l * NE * 1024}, c.wv);
}
__device__ __forceinline__ void ph_moe_down(const Ctx& c) {
    LAS int* tb = (LAS int*)(c.lds + 131072);
    const int Gm = MOE_G(c);
    MoeDown S; S.tb = tb; S.G = Gm; S.c = c.bid;
    if (Gm < c.G) { S.tlim = 5 * (Gm >> 2); if (c.bid >= Gm) { S.tail0 = S.tlim; S.G = c.G - Gm; S.c = c.bid - Gm; } }
    S.T = __builtin_amdgcn_readfirstlane(tb[NE]); S.flip = true; S.tc = WSP(unsigned, WS_TC) + (size_t)c.l * 288 * 64; S.tmo = WSP(unsigned, WS_CTL) + XB_TMO;
    eng::gemm_phase(c.lds, eng::Geo{DE * 2, 128, 128, DE / 64}, WSP(h16, WS_R1), WD_SET(c.l), S, EpiScat{WSP(unsigned char, WS_R3), WSP(float, WS_R3 + 64 * MiB), WSP(const unsigned, WS_LIST), tb}, c.wv);
}
__device__ __forceinline__ void ph_combine(const Ctx& c) {
    OPQ(); const h16* X16 = WSP(const h16, WS_HH); h16* Xo = c.probe ? WSP(h16, WS_R1) : WSP(h16, WS_HH); float* RR0 = c.probe ? WSP(float, WS_R1 + 128 * MiB) : WSP(float, WS_RR0);
    const unsigned* YS8 = WSP(const unsigned, WS_R3); const float* YSC = WSP(const float, WS_R3 + 64 * MiB); const bool lastl = (c.l == DEPTH - 1) && !c.probe; const float* gfin = c.in[27]; unsigned* X8 = WSP(unsigned, WS_X8);
    const int NW = c.G * NWAVES;
    for (int row0 = c.bid * NWAVES + wave; row0 < NTOK; row0 += 2 * NW) {
        h16x4 xv[2][4]; unsigned ya[2][4], yb[2][4]; float sa[2][4], sb[2][4];
#pragma unroll
        for (int t = 0; t < 2; ++t) { const int row = row0 + t * NW < NTOK ? row0 + t * NW : row0;
            const h16x4* xr = (const h16x4*)(X16 + (size_t)row * DM) + lane; const unsigned* pa = YS8 + (size_t)row * 2 * (DM / 4) + (((lane & 31) >> 3) * 16 + ((lane & 7) >> 1) * 4 + (lane >> 5) * 2 + (lane & 1)); const unsigned* pb = pa + DM / 4;
            const float* qa = YSC + (size_t)row * 32 + ((lane & 31) >> 3);
#pragma unroll
            for (int j = 0; j < 4; ++j) { xv[t][j] = xr[64 * j]; ya[t][j] = __builtin_nontemporal_load(pa + 64 * j); yb[t][j] = __builtin_nontemporal_load(pb + 64 * j); sa[t][j] = qa[j * 4]; sb[t][j] = qa[16 + j * 4]; } }
#pragma unroll
        for (int t = 0; t < 2; ++t) { const int row = row0 + t * NW; if (row >= NTOK) break;
            f32x4 v[4]; float s = 0.f;
#pragma unroll
            for (int j = 0; j < 4; ++j) { const h16x4 x = xv[t][j]; const unsigned a = ya[t][j], b = yb[t][j]; const float fa = sa[t][j], fb = sb[t][j], off = -128.0f * (fa + fb);
                const f32x4 ua = {(float)(a & 255u), (float)((a >> 8) & 255u), (float)((a >> 16) & 255u), (float)(a >> 24)}, ub = {(float)(b & 255u), (float)((b >> 8) & 255u), (float)((b >> 16) & 255u), (float)(b >> 24)};
                v[j] = (f32x4){(float)x[0], (float)x[1], (float)x[2], (float)x[3]} + ((ua * fa + ub * fb) + off); }
            if (!lastl) { h16x4* xw = (h16x4*)(Xo + (size_t)row * DM) + lane; float am = 0.f;
#pragma unroll
                for (int j = 0; j < 4; ++j) { h16x4 h;
#pragma unroll
                    for (int e = 0; e < 4; ++e) { h[e] = (h16)v[j][e]; const float f = (float)h[e]; v[j][e] = f; s += f * f; am = fmaxf(am, fabsf(f)); }
                    xw[64 * j] = h; }
                const float r = 1.0f / sqrtf(wave_sum(s, lane) * (1.0f / DM) + eps_());
                am = wave_max(am, lane); const float inv = am > 1e-30f ? 127.0f / am : 0.f;
#pragma unroll
                for (int j = 0; j < 4; ++j) X8[(size_t)row * (DM / 4) + lane + 64 * j] = pk_i8(v[j][0], v[j][1], v[j][2], v[j][3], inv);
                if (lane == 0) RR0[row] = r * am * (1.0f / (127.0f * 127.0f)); }
            else {
#pragma unroll
                for (int j = 0; j < 4; ++j) s += v[j][0] * v[j][0] + v[j][1] * v[j][1] + v[j][2] * v[j][2] + v[j][3] * v[j][3];
                const float r = 1.0f / sqrtf(wave_sum(s, lane) * (1.0f / DM) + eps_());
                f32x4* orow = (f32x4*)(c.out + (size_t)row * DM) + lane;
#pragma unroll
                for (int j = 0; j < 4; ++j) { const f32x4 gv = ((const f32x4*)gfin)[lane + 64 * j]; __builtin_nontemporal_store(v[j] * r * gv, orow + 64 * j); } }
        }
    }
}
#undef WSP
#undef OPQ

__device__ __forceinline__ void xcd_barrier_bg(const XcdBarrier& b, volatile LAS unsigned* relw, unsigned gen, const Ctx& c, int lw, int& done) {
    asm volatile("s_waitcnt vmcnt(0)" ::: "memory");
    __syncthreads();
    int tid = c.wv * 64 + lane_id_(); asm volatile("" : "+v"(tid)); const int lane = tid & 63, wave = __builtin_amdgcn_readfirstlane(tid >> 6);
    if (wave == 0) {
        if (tid == 0) {
            unsigned* bar = b.bar;
            __builtin_amdgcn_s_waitcnt(0);
            unsigned nloc = b.st[0], nx = b.st[1];
            if (nloc == 0u) { xcd_barrier_complete(bar, b.x, nloc, nx); b.st[0] = nloc; b.st[1] = nx; }
            const unsigned old = xb_add(&bar[XB_XSUB(b.x)], 1u);
            const unsigned g2 = old / nloc;
            if (old + 1u == (g2 + 1u) * nloc) {
                __builtin_amdgcn_fence(__ATOMIC_RELEASE, "agent");
                asm volatile("s_waitcnt vmcnt(0)" ::: "memory");
                const unsigned og = xb_add(&bar[XB_TOP], 1u);
                const unsigned tg = og / nx;
                if (og + 1u == (tg + 1u) * nx) xb_add(&bar[XB_TOPGEN], 1u);
                else XB_SPIN(xb_ld(&bar[XB_TOPGEN]) == tg, bar);
                __builtin_amdgcn_fence(__ATOMIC_ACQUIRE, "agent");
                xb_add(&bar[XB_XGEN(b.x)], 1u);
                asm volatile("s_waitcnt vmcnt(0)" ::: "memory");
            } else {
                XB_SPIN(xb_ld(&bar[XB_XGEN(b.x)]) == g2, bar);
                __builtin_amdgcn_fence(__ATOMIC_ACQUIRE, "agent");
                asm volatile("s_waitcnt vmcnt(0)" ::: "memory");
            }
            *relw = gen;
        }
    } else if (BG_CONVERT && lw >= 1 && lw < DEPTH) {
        LAS float* scr = (LAS float*)(c.lds + wave * 17408); const int gw = c.bid * NWAVES + wave, NGW = c.G * NWAVES;
        while (*relw != gen && gw + done * NGW < NITE) { expert_item(c, lw, gw + done * NGW, scr, lane); ++done; }
    }
    __syncthreads();
}

__global__ void __launch_bounds__(NTHREADS, 2) fwd(Args args) {
    extern __shared__ __attribute__((aligned(16))) unsigned char lds_raw[];
    LAS unsigned char* lds = (LAS unsigned char*)lds_raw;
    const int tid0 = threadIdx.x; const int swv = __builtin_amdgcn_readfirstlane(tid0 >> 6);
    volatile LAS unsigned* MISC = (volatile LAS unsigned*)(lds + LDS_BYTES - 64);
    if (tid0 < 16) MISC[tid0] = 0u;
    __syncthreads();
    XcdBarrier bar; bar.bar = (unsigned*)(args.ws + WS_CTL); bar.x = 0; bar.st = nullptr;
    if (MK_ONE_LAUNCH) bar = xcd_barrier_post((unsigned*)(args.ws + WS_CTL), MISC);
    const int lo = args.ph_lo, hi = args.ph_hi;
#define IN(k) (lo <= (k) && (k) < hi)
    unsigned bgen = 0u; int bg_done = 0;
#define SEAM(k) do { if (IN(k) && IN((k) + 1)) { int l_ = l + 1; GAS unsigned char* w_ = (GAS unsigned char*)args.ws; asm volatile("" : "+s"(l_), "+s"(w_)); Ctx c_{args.in, args.out, w_, lds, l_, (int)gridDim.x, (int)blockIdx.x, 0, swv}; \
        ++bgen; xcd_barrier_bg(bar, MISC + 4, bgen, c_, l_, bg_done); } } while (0)
#define RUN(k, fn) do { for (int rep_ = 0; rep_ < ((((DUP_MASK) >> ((k) % PPL)) & 1) && (k) < DEPTH * PPL ? 2 : 1); ++rep_) if (IN(k)) { int l_ = l; GAS unsigned char* w_ = (GAS unsigned char*)args.ws; asm volatile("" : "+s"(l_), "+s"(w_)); Ctx c_{args.in, args.out, w_, lds, l_, (int)gridDim.x, (int)blockIdx.x, rep_, swv}; fn(c_); } } while (0)
    for (int l = 0; l < DEPTH; ++l) {
        const int pb = l * PPL;
        if (l == 0) { RUN(pb + 0, ph_wmax); RUN(pb + 0, ph_norm_in); RUN(pb + 0, ph_tables);
            if (IN(pb + 0)) { int l_ = l + 1; GAS unsigned char* w_ = (GAS unsigned char*)args.ws; asm volatile("" : "+s"(l_), "+s"(w_)); Ctx c_{args.in, args.out, w_, lds, l_, (int)gridDim.x, (int)blockIdx.x, 0, swv};
                ++bgen; xcd_barrier_bg(bar, MISC + 4, bgen, c_, l_, bg_done); }
            RUN(pb + 0, ph_weights); RUN(pb + 0, ph_wstrips); SEAM(pb + 0); }
        RUN(pb + 1, ph_gemm_in); SEAM(pb + 1);
        RUN(pb + 2, ph_ssm_s); RUN(pb + 2, ph_conv); SEAM(pb + 2);
        RUN(pb + 5, ph_gemm_glu); SEAM(pb + 5);
        RUN(pb + 7, ph_gemm_out); SEAM(pb + 7);
        RUN(pb + 8, ph_router); SEAM(pb + 8);
#define MOE_TB() do { int l_ = l; GAS unsigned char* w_ = (GAS unsigned char*)args.ws; asm volatile("" : "+s"(l_), "+s"(w_)); Ctx c_{args.in, args.out, w_, lds, l_, (int)gridDim.x, (int)blockIdx.x, 0, swv}; ph_moe_tb(c_); } while (0)
        if (IN(pb + 9)) MOE_TB();
        RUN(pb + 9, ph_convert);
        if (IN(pb + 9) && l + 1 < DEPTH && (int)blockIdx.x >= (int)gridDim.x - NCONV) MOE_TB();
        RUN(pb + 9, ph_moe_gu);
        RUN(pb + 9, ph_moe_down); SEAM(pb + 10);
        RUN(pb + 11, ph_combine);
        if (l + 1 < DEPTH) { const int lcur = l; { const int l = lcur + 1; RUN(pb + 11, ph_tables); RUN(pb + 11, ph_weights); }
            }
        bg_done = NITE;
        SEAM(pb + 11);
        bg_done = 0;
    }
#undef IN
#undef SEAM
#undef RUN
#undef MOE_TB
}
}

extern "C" void kernel_launch(void* const* d_in, const int* in_sizes, int n_in, void* d_out, int out_size, void* d_ws, size_t ws_size, hipStream_t stream) {
    static int grid = 0;
    if (grid == 0) {
        if (n_in != 28 || out_size != NTOK * DM || ws_size < WS_END) { fprintf(stderr, "kernel_launch: unexpected shapes (n_in %d out %d ws %zu need %zu)\n", n_in, out_size, ws_size, (size_t)WS_END); grid = -1; return; }
        int dev = 0, cus = 0;
        if (hipGetDevice(&dev) != hipSuccess || hipDeviceGetAttribute(&cus, hipDeviceAttributeMultiprocessorCount, dev) != hipSuccess) { grid = -1; return; }
        if (hipFuncSetAttribute((const void*)fwd, hipFuncAttributeMaxDynamicSharedMemorySize, LDS_BYTES) != hipSuccess) { fprintf(stderr, "kernel_launch: hipFuncSetAttribute failed\n"); grid = -1; return; }
        int per_cu = 0;
        if (hipOccupancyMaxActiveBlocksPerMultiprocessor(&per_cu, (const void*)fwd, NTHREADS, LDS_BYTES) != hipSuccess || per_cu < 1) { fprintf(stderr, "kernel_launch: occupancy query says %d\n", per_cu); }
        (void)hipGetLastError();
        if (cus < 256) { fprintf(stderr, "kernel_launch: needs >= 256 CUs (has %d): the output projection keeps the row factors of at most two units per workgroup in LDS\n", cus); grid = -1; return; }
        grid = cus;
    }
    if (grid < 0) return;
    (void)hipMemsetAsync((char*)d_ws + WS_CTL, 0, ZERO_BYTES, stream);
    Args a{};
    for (int i = 0; i < 28; ++i) a.in[i] = (const float*)d_in[i];
    a.out = (float*)d_out; a.ws = (unsigned char*)d_ws;
#if MK_ONE_LAUNCH
    a.ph_lo = 0; a.ph_hi = NPH;
    hipLaunchKernelGGL(fwd, dim3(grid), dim3(NTHREADS), LDS_BYTES, stream, a);
#else
    for (int p = 0; p < NPH; ++p) { a.ph_lo = p; a.ph_hi = p + 1; hipLaunchKernelGGL(fwd, dim3(grid), dim3(NTHREADS), LDS_BYTES, stream, a); }
#endif
}
```
